# Optimizing an MI355X kernel written in HIP

```python
import jax, jax.numpy as jnp
from jax import lax
import numpy as np

D_MODEL = 1024
BATCH = 16
SEQ = 2048
DEPTH = 2
DEC_BATCH = 8
DEC_SEQ = 2048
PAST_LEN = 128

GRID_W = 64
N_MIXERS = 2
N_A_LAYERS = (DEPTH + 1) // 2
N_B_LAYERS = DEPTH // 2
NA_HEADS = 16
NA_HEAD_DIM = D_MODEL // NA_HEADS
WIN_R = 8
WIN_C = 16
N_COL_BLK = GRID_W // WIN_C
KEY_COLS = 2 * WIN_C
FN_GROUPS = 4
FN_GROUP_DIM = D_MODEL // FN_GROUPS
N_EXPERTS = 16
EC_FACTOR = 2
EXPERT_FF = 2048
N_MOD = 6
EPS = 1e-6
NEG = -1e30

kernel_name = 'hybrid_natten_fnet_ec_moe_encoder'


def _rms(x, g):
    xf = x.astype(jnp.float32)
    y = xf * lax.rsqrt(jnp.mean(xf * xf, axis=-1, keepdims=True) + EPS)
    return (y * g.astype(jnp.float32)).astype(x.dtype)


def _col_tables():
    j = np.arange(N_COL_BLK)
    kc0 = np.clip(j * WIN_C - WIN_C // 2, 0, GRID_W - KEY_COLS)
    key_col = kc0[:, None] + np.arange(KEY_COLS)[None, :]
    q_col = j[:, None] * WIN_C + np.arange(WIN_C)[None, :]
    start = np.clip(q_col - WIN_C // 2, 0, GRID_W - WIN_C)
    rel = key_col[:, None, :] - start[:, :, None]
    mask = (rel >= 0) & (rel < WIN_C)
    dcol = np.clip(key_col[:, None, :] - q_col[:, :, None] + WIN_C - 1, 0, 2 * WIN_C - 2)
    return key_col, mask, dcol


def neighbourhood_attention(h, w_qkv, q_g, k_g, rpb, w_o):
    B, T, D = h.shape
    rows = T // GRID_W
    kr = min(WIN_R, rows)
    q, k, v = jnp.split(h @ w_qkv, 3, axis=-1)
    shp = (B, rows, GRID_W, NA_HEADS, NA_HEAD_DIM)
    q = _rms(q.reshape(shp), q_g) * (NA_HEAD_DIM ** -0.5)
    k = _rms(k.reshape(shp), k_g)
    v = v.reshape(shp)
    key_col, mask_np, dcol = _col_tables()
    mask = jnp.asarray(mask_np)[:, :, None, :]

    def row_block(r):
        rs = jnp.clip(r - kr // 2, 0, rows - kr)
        k_rows = lax.dynamic_slice_in_dim(k, rs, kr, axis=1)
        v_rows = lax.dynamic_slice_in_dim(v, rs, kr, axis=1)
        k_blk = k_rows[:, :, key_col]
        v_blk = v_rows[:, :, key_col]
        q_row = lax.dynamic_index_in_dim(q, r, axis=1, keepdims=False)
        q_row = q_row.reshape(B, N_COL_BLK, WIN_C, NA_HEADS, NA_HEAD_DIM)
        s = jnp.einsum('bjqhd,brjkhd->bhjqrk', q_row, k_blk).astype(jnp.float32)
        drow = rs + jnp.arange(kr) - r + WIN_R - 1
        bias = rpb[:, drow[None, None, :, None], dcol[:, :, None, :]]
        s = jnp.where(mask, s + bias.astype(jnp.float32), NEG)
        p = jax.nn.softmax(s.reshape(s.shape[:4] + (kr * KEY_COLS,)), axis=-1)
        p = p.reshape(s.shape).astype(v.dtype)
        o = jnp.einsum('bhjqrk,brjkhd->bjqhd', p, v_blk)
        return o.reshape(B, GRID_W, NA_HEADS, NA_HEAD_DIM)

    o = lax.map(row_block, jnp.arange(rows))
    o = jnp.moveaxis(o, 0, 1).reshape(B, T, D)
    return o @ w_o


def fourier_mixer(h, w_in, w_out):
    B, T, D = h.shape
    u = (h @ w_in).astype(jnp.float32).reshape(B, T, FN_GROUPS, FN_GROUP_DIM)
    f = jnp.fft.fft2(u, axes=(1, 3), norm='ortho').real
    return f.reshape(B, T, D).astype(h.dtype) @ w_out


def expert_choice_ffn(h, w_router, w_gate, w_up, w_down):
    B, T, D = h.shape
    n = B * T
    cap = max(1, EC_FACTOR * n // N_EXPERTS)
    xt = h.reshape(n, D)
    aff = jax.nn.softmax((xt @ w_router).astype(jnp.float32), axis=-1)
    g, idx = lax.top_k(aff.T, cap)
    xe = xt[idx]
    a = jnp.einsum('ecd,edf->ecf', xe, w_gate)
    b = jnp.einsum('ecd,edf->ecf', xe, w_up)
    ye = jnp.einsum('ecf,efd->ecd', jax.nn.silu(a) * b, w_down)
    ye = ye * g[..., None].astype(ye.dtype)
    out = jnp.zeros_like(xt).at[idx.reshape(-1)].add(ye.reshape(-1, D))
    return out.reshape(B, T, D)


def trunk(x, c, norm1_g, norm2_g, ada_w, ada_b, na_w_qkv, na_q_g, na_k_g, na_rpb, na_w_o,
          fn_w_in, fn_w_out, moe_w_router, moe_w_gate, moe_w_up, moe_w_down):
    for i in range(DEPTH):
        mod = jax.nn.silu(c) @ ada_w[i] + ada_b[i]
        sh1, sc1, g1, sh2, sc2, g2 = [m[:, None, :] for m in jnp.split(mod, N_MOD, axis=-1)]
        h = _rms(x, norm1_g[i]) * (1 + sc1) + sh1
        j = i // N_MIXERS
        if i % N_MIXERS == 0:
            m = neighbourhood_attention(h, na_w_qkv[j], na_q_g[j], na_k_g[j], na_rpb[j], na_w_o[j])
        else:
            m = fourier_mixer(h, fn_w_in[j], fn_w_out[j])
        x = x + g1 * m
        h = _rms(x, norm2_g[i]) * (1 + sc2) + sh2
        x = x + g2 * expert_choice_ffn(h, moe_w_router[i], moe_w_gate[i], moe_w_up[i], moe_w_down[i])
    return x


def setup_inputs(seed: int = 0) -> dict:
    key = jax.random.key(seed)
    ks = jax.random.split(key, 20)
    D, F, E, H = D_MODEL, EXPERT_FF, N_EXPERTS, NA_HEADS
    nrm = lambda k, shp, s: jax.random.normal(k, shp, jnp.float32) * s
    return {
        'x_prompt': nrm(ks[0], (BATCH, SEQ, D), 1.0),
        'x_sample': nrm(ks[1], (DEC_BATCH, DEC_SEQ, D), 1.0),
        'c_prompt': nrm(ks[2], (BATCH, D), 1.0),
        'c_sample': nrm(ks[3], (DEC_BATCH, D), 1.0),
        'norm1_g': 1.0 + nrm(ks[4], (DEPTH, D), 0.02),
        'norm2_g': 1.0 + nrm(ks[5], (DEPTH, D), 0.02),
        'ada_w': nrm(ks[6], (DEPTH, D, N_MOD * D), 0.5 * D ** -0.5),
        'ada_b': nrm(ks[7], (DEPTH, N_MOD * D), 0.02),
        'na_w_qkv': nrm(ks[8], (N_A_LAYERS, D, 3 * D), D ** -0.5),
        'na_q_g': 1.0 + nrm(ks[9], (N_A_LAYERS, NA_HEAD_DIM), 0.02),
        'na_k_g': 1.0 + nrm(ks[10], (N_A_LAYERS, NA_HEAD_DIM), 0.02),
        'na_rpb': nrm(ks[11], (N_A_LAYERS, H, 2 * WIN_R - 1, 2 * WIN_C - 1), 0.1),
        'na_w_o': nrm(ks[12], (N_A_LAYERS, D, D), D ** -0.5),
        'fn_w_in': nrm(ks[13], (N_B_LAYERS, D, D), D ** -0.5),
        'fn_w_out': nrm(ks[14], (N_B_LAYERS, D, D), D ** -0.5),
        'moe_w_router': nrm(ks[15], (DEPTH, D, E), D ** -0.5),
        'moe_w_gate': nrm(ks[16], (DEPTH, E, D, F), D ** -0.5),
        'moe_w_up': nrm(ks[17], (DEPTH, E, D, F), D ** -0.5),
        'moe_w_down': nrm(ks[18], (DEPTH, E, F, D), F ** -0.5),
    }


def reference(x_prompt, x_sample, c_prompt, c_sample, norm1_g, norm2_g, ada_w, ada_b,
              na_w_qkv, na_q_g, na_k_g, na_rpb, na_w_o, fn_w_in, fn_w_out,
              moe_w_router, moe_w_gate, moe_w_up, moe_w_down):
    y_prompt = trunk(x_prompt, c_prompt, norm1_g, norm2_g, ada_w, ada_b, na_w_qkv, na_q_g, na_k_g,
                     na_rpb, na_w_o, fn_w_in, fn_w_out, moe_w_router, moe_w_gate, moe_w_up, moe_w_down)
    y_sample = trunk(x_sample, c_sample, norm1_g, norm2_g, ada_w, ada_b, na_w_qkv, na_q_g, na_k_g,
                     na_rpb, na_w_o, fn_w_in, fn_w_out, moe_w_router, moe_w_gate, moe_w_up, moe_w_down)
    return (y_prompt, y_sample)
```

```cpp
#include <hip/hip_runtime.h>
#include <cstdio>
#include <cstdint>

#ifndef MK_N_LAUNCHES
#define MK_N_LAUNCHES 1
#endif
#ifndef DUP_MASK
#define DUP_MASK 0
#endif

namespace pg8 {
#define PG8_LAS __attribute__((address_space(3)))
typedef unsigned short bf16_t;
typedef short bf16x8 __attribute__((ext_vector_type(8)));
typedef float f32x4 __attribute__((ext_vector_type(4)));
typedef unsigned u32x4 __attribute__((ext_vector_type(4)));
constexpr int BM = 256, BK = 64, HALF = 128, HTB = HALF * BK * 2, STAGE_BYTES = 8 * HTB, NXCD = 8, WGM = 8;

__host__ __device__ __forceinline__ int lds_byte(int r, int c) { const int st = (r >> 4) * 2 + (c >> 5), rr = r & 15, cc = c & 31, ob = rr * 64 + cc * 2; return st * 1024 + (ob ^ (((ob >> 9) & 1) << 5)); }
__host__ __device__ __forceinline__ void stage_rc(int b, int& R, int& C) { const int st = b / 1024, sb = b % 1024, swz = sb ^ (((sb >> 9) & 1) << 5); R = (st >> 1) * 16 + swz / 64; C = (st & 1) * 32 + (swz % 64) / 2; }
__host__ __device__ __forceinline__ int perm32(int rho) { const int n = rho >> 4, i = rho & 15; return 8 * (i >> 2) + 4 * n + (i & 3); }

struct Unit { int pm, pn; const char* A; const char* B; };

struct OrderBase {
    int nM, nN, nwg, G, c;
    __device__ __forceinline__ void init(int nM_, int nN_, int G_, int c_) { nM = nM_; nN = nN_; nwg = nM * nN; G = G_; c = c_; }
    __device__ __forceinline__ bool idx(int i, int& pm, int& pn) const {
        const long L = (long)i * G + c; if (L >= nwg) return false;
        int wgid = (int)L; { const int q = nwg / NXCD, r = nwg % NXCD, xcd = wgid % NXCD, off = wgid / NXCD; wgid = (xcd < r ? xcd * (q + 1) : r * (q + 1) + (xcd - r) * q) + off; }
        const int nig = WGM * nN, gid = wgid / nig, fm = gid * WGM, gsz = (nM - fm) < WGM ? (nM - fm) : WGM;
        pm = fm + ((wgid % nig) % gsz); pn = (wgid % nig) / gsz; return true;
    }
};

__device__ __forceinline__ const char* uptr(const char* p) { const unsigned long long v = (unsigned long long)p; const unsigned lo = __builtin_amdgcn_readfirstlane((unsigned)v), hi = __builtin_amdgcn_readfirstlane((unsigned)(v >> 32)); return (const char*)(((unsigned long long)hi << 32) | lo); }
__device__ __forceinline__ unsigned cvt_pk_bf16(float lo, float hi) { unsigned r; asm volatile("v_cvt_pk_bf16_f32 %0, %1, %2" : "=v"(r) : "v"(lo), "v"(hi)); return r; }

typedef int i32x4 __attribute__((ext_vector_type(4)));
typedef int i32x8 __attribute__((ext_vector_type(8)));
__device__ __forceinline__ i32x8 cat8(bf16x8 lo, bf16x8 hi) { const i32x4 a = __builtin_bit_cast(i32x4, lo), b = __builtin_bit_cast(i32x4, hi); return __builtin_shufflevector(a, b, 0, 1, 2, 3, 4, 5, 6, 7); }
#define PG8_GOFF(unit, h, i) (gtab[(unit) * 256 + (h) * 128 + gri[i]] + gcb[i])
template <class Epi, class Sched, bool ALIGN_EPI = true, bool FP8 = false, bool GATHER = false, bool OWN_TID = false, bool PEEL = false, int HWS = 0>
__device__ __forceinline__ void gemm_phase(PG8_LAS unsigned char* lds, const int Kb, const int lda, const int ldb, const Sched& S, const Epi& E, const PG8_LAS unsigned* gtab, const int tid_in, const size_t hstepB_over = 0) {
    int tid = tid_in; if constexpr (OWN_TID) asm volatile("" : "+v"(tid));
    __builtin_assume((unsigned)tid < 512u);
    const int wid = __builtin_amdgcn_readfirstlane(tid >> 6), lane = tid & 63, wr = wid >> 2, wc = wid & 3, fr = lane & 15, fq = lane >> 4;
    const int nt = Kb / (BK * 2);
    unsigned voffA[2], voffB[2];
#pragma unroll
    for (int i = 0; i < 2; ++i) { int R, C; stage_rc(tid * 16 + i * 8192, R, C); const int Rb = Epi::PERM ? ((R & ~31) + perm32(R & 31)) : R;
        voffA[i] = (unsigned)(R * lda + C * 2); voffB[i] = (unsigned)(Rb * ldb + C * 2); }
    const size_t kstep = (size_t)(BK * 2);
    const size_t hstepA = (size_t)HALF * lda, hstepB = hstepB_over ? hstepB_over : (size_t)HALF * ldb;
    const unsigned ldsw = (unsigned)wid * 1024u;
    const int aoff = lds_byte(wr * 64 + fr, fq * 8), boff = lds_byte(wc * 32 + fr, fq * 8);
#define PG8_SA(b, h) (((b) * 2 + (h)) * HTB)
#define PG8_SB(b, h) ((4 + (b) * 2 + (h)) * HTB)
#define PG8_STAGE(bufoff, gbase, voff) do { _Pragma("unroll") for (int _i = 0; _i < 2; ++_i) \
        __builtin_amdgcn_global_load_lds((const unsigned*)((const char*)(gbase) + (voff)[_i]), (PG8_LAS unsigned*)(lds + (bufoff) + ldsw + _i * 8192), 16, 0, 0); } while (0)
#define PG8_STAGE_A(bufoff, gbase, h, usenext) do { if constexpr (GATHER) { const unsigned n0_ = PG8_GOFF(ui + 1, h, 0), n1_ = PG8_GOFF(ui + 1, h, 1), o0_ = (usenext) ? n0_ : gc[h][0], o1_ = (usenext) ? n1_ : gc[h][1];     \
            __builtin_amdgcn_global_load_lds((const unsigned*)((const char*)(gbase) + o0_), (PG8_LAS unsigned*)(lds + (bufoff) + ldsw), 16, 0, 0); \
            __builtin_amdgcn_global_load_lds((const unsigned*)((const char*)(gbase) + o1_), (PG8_LAS unsigned*)(lds + (bufoff) + ldsw + 8192), 16, 0, 0); } \
        else { PG8_STAGE(bufoff, (gbase) + (h) * hstepA, voffA); } } while (0)
#define PG8_LDA(dst, b, h) do { if constexpr (FP8) { _Pragma("unroll") for (int m = 0; m < 4; ++m) { const i32x4 lo_ = *(const PG8_LAS i32x4*)(lds + PG8_SA(b, h) + aoff + m * 2048), hi_ = *(const PG8_LAS i32x4*)(lds + PG8_SA(b, h) + aoff + m * 2048 + 1024); dst##8[m] = __builtin_shufflevector(lo_, hi_, 0, 1, 2, 3, 4, 5, 6, 7); } } \
        else { _Pragma("unroll") for (int m = 0; m < 4; ++m) _Pragma("unroll") for (int k = 0; k < 2; ++k) dst[m][k] = *(const PG8_LAS bf16x8*)(lds + PG8_SA(b, h) + aoff + m * 2048 + k * 1024); } } while (0)
#define PG8_LDB(dst, b, h) do { if constexpr (FP8) { _Pragma("unroll") for (int n = 0; n < 2; ++n) { const i32x4 lo_ = *(const PG8_LAS i32x4*)(lds + PG8_SB(b, h) + boff + n * 2048), hi_ = *(const PG8_LAS i32x4*)(lds + PG8_SB(b, h) + boff + n * 2048 + 1024); dst##8[n] = __builtin_shufflevector(lo_, hi_, 0, 1, 2, 3, 4, 5, 6, 7); } } \
        else { _Pragma("unroll") for (int n = 0; n < 2; ++n) _Pragma("unroll") for (int k = 0; k < 2; ++k) dst[n][k] = *(const PG8_LAS bf16x8*)(lds + PG8_SB(b, h) + boff + n * 2048 + k * 1024); } } while (0)
#define PG8_MMA(ai, bj, At, Bt, Z) do { __builtin_amdgcn_s_setprio(1); \
        if constexpr (FP8) { _Pragma("unroll") for (int m = 0; m < 4; ++m) _Pragma("unroll") for (int n = 0; n < 2; ++n) \
            acc[ai][bj][m][n] = __builtin_amdgcn_mfma_scale_f32_16x16x128_f8f6f4(Bt##8[n], At##8[m], (Z) ? (f32x4){0.f, 0.f, 0.f, 0.f} : acc[ai][bj][m][n], 0, 0, 0, 0x7f7f7f7f, 0, 0x01010101 * (127 - HWS)); } \
        else { _Pragma("unroll") for (int m = 0; m < 4; ++m) _Pragma("unroll") for (int n = 0; n < 2; ++n) _Pragma("unroll") for (int k = 0; k < 2; ++k) \
            acc[ai][bj][m][n] = __builtin_amdgcn_mfma_f32_16x16x32_bf16(Bt[n][k], At[m][k], ((Z) && k == 0) ? (f32x4){0.f, 0.f, 0.f, 0.f} : acc[ai][bj][m][n], 0, 0, 0); } \
        __builtin_amdgcn_s_setprio(0); } while (0)
#define PG8_WAIT_V(n) asm volatile("s_waitcnt vmcnt(" #n ")" ::: "memory")
#define PG8_WAIT_L(n) asm volatile("s_waitcnt lgkmcnt(" #n ")" ::: "memory")
#define PG8_BAR __builtin_amdgcn_s_barrier()
#define PG8_SCHED __builtin_amdgcn_sched_barrier(0)
    Unit cur, nxt; int ui = 0;
    if (!S.next(0, cur)) return;
    f32x4 acc[2][2][4][2];
    if constexpr (!PEEL)
#pragma unroll
    for (int a = 0; a < 2; ++a)
#pragma unroll
        for (int b = 0; b < 2; ++b)
#pragma unroll
            for (int m = 0; m < 4; ++m)
#pragma unroll
                for (int n = 0; n < 2; ++n) acc[a][b][m][n] = (f32x4){0.f, 0.f, 0.f, 0.f};
    bf16x8 At[4][2], B0[2][2], B1[2][2];
    i32x8 At8[4], B08[2], B18[2];
    const char* cA = uptr(cur.A); const char* cB = uptr(cur.B);
    unsigned gc[2][2];
    int gri[2]; unsigned gcb[2];
    if constexpr (GATHER) {
#pragma unroll
        for (int i = 0; i < 2; ++i) { int R, C; stage_rc(tid * 16 + i * 8192, R, C); gri[i] = R; gcb[i] = (unsigned)(C * 2); }
#pragma unroll
        for (int h = 0; h < 2; ++h)
#pragma unroll
            for (int i = 0; i < 2; ++i) gc[h][i] = PG8_GOFF(0, h, i);
    }
    PG8_STAGE(PG8_SB(0, 0), cB, voffB); PG8_STAGE(PG8_SB(0, 1), cB + hstepB, voffB); PG8_STAGE_A(PG8_SA(0, 0), cA, 0, false); PG8_STAGE_A(PG8_SA(0, 1), cA, 1, false);
    if (wr == 1) PG8_BAR;
    PG8_WAIT_V(2); PG8_BAR;
    PG8_STAGE(PG8_SB(1, 0), cB + kstep, voffB); PG8_STAGE_A(PG8_SA(1, 0), cA + kstep, 0, false); PG8_STAGE(PG8_SB(1, 1), cB + hstepB + kstep, voffB);
    PG8_WAIT_V(6); PG8_BAR;
    for (;;) {
        const bool has_next = S.next(ui + 1, nxt);
        const char* nA = has_next ? nxt.A : cA; const char* nB = has_next ? nxt.B : cB;
#define PG8_ITER(t, Z) do { \
            const bool last = ((t) == nt - 2); const bool usenext = last && has_next;     \
            if constexpr (GATHER) { asm volatile("" : "+v"(voffB[0]), "+v"(voffB[1])); asm volatile("" : "+v"(gc[0][0]), "+v"(gc[0][1]), "+v"(gc[1][0]), "+v"(gc[1][1])); } \
            else asm volatile("" : "+v"(voffA[0]), "+v"(voffA[1]), "+v"(voffB[0]), "+v"(voffB[1]));     \
            const char* a1 = cA + (size_t)((t) + 1) * kstep; \
            const char* a2 = last ? nA : cA + (size_t)((t) + 2) * kstep; const char* b2 = last ? nB : cB + (size_t)((t) + 2) * kstep; \
            const char* a3 = a2 + kstep; const char* b3 = b2 + kstep; \
            a1 = uptr(a1); a2 = uptr(a2); a3 = uptr(a3); b2 = uptr(b2); b3 = uptr(b3);     \
  \
            PG8_LDB(B0, 0, 0); PG8_LDB(B1, 0, 1); PG8_SCHED; PG8_LDA(At, 0, 0); PG8_STAGE_A(PG8_SA(1, 1), a1, 1, false); \
            PG8_WAIT_V(8); PG8_WAIT_L(0); PG8_BAR; PG8_MMA(0, 0, At, B0, Z); PG8_MMA(0, 1, At, B1, Z); PG8_BAR; PG8_SCHED; \
  \
            PG8_LDA(At, 0, 1); PG8_STAGE(PG8_SB(0, 0), b2, voffB); PG8_STAGE(PG8_SB(0, 1), b2 + hstepB, voffB); PG8_STAGE_A(PG8_SA(0, 0), a2, 0, usenext); \
            PG8_WAIT_V(8); PG8_WAIT_L(0); PG8_BAR; PG8_MMA(1, 0, At, B0, Z); PG8_MMA(1, 1, At, B1, Z); PG8_BAR; PG8_SCHED; \
  \
            PG8_LDB(B0, 1, 0); PG8_LDB(B1, 1, 1); PG8_SCHED; PG8_LDA(At, 1, 0); PG8_STAGE_A(PG8_SA(0, 1), a2, 1, usenext); \
            PG8_WAIT_V(8); PG8_WAIT_L(0); PG8_BAR; PG8_MMA(0, 0, At, B0, 0); PG8_MMA(0, 1, At, B1, 0); PG8_BAR; PG8_SCHED; \
  \
            PG8_LDA(At, 1, 1); PG8_STAGE(PG8_SB(1, 0), b3, voffB); PG8_STAGE(PG8_SB(1, 1), b3 + hstepB, voffB); PG8_STAGE_A(PG8_SA(1, 0), a3, 0, usenext); \
            PG8_WAIT_V(8); PG8_WAIT_L(0); PG8_BAR; PG8_MMA(1, 0, At, B0, 0); PG8_MMA(1, 1, At, B1, 0); PG8_BAR; PG8_SCHED; \
        } while (0)
        if constexpr (PEEL) { PG8_ITER(0, 1);
#pragma nounroll
            for (int t = 2; t < nt; t += 2) PG8_ITER(t, 0); }
        else {
#pragma nounroll
            for (int t = 0; t < nt; t += 2) PG8_ITER(t, 0); }
        if constexpr (ALIGN_EPI) { if (wr == 0) PG8_BAR; }
        E(acc, cur, wr, wc, fr, fq);
        if (!has_next) break;
        if constexpr (!PEEL)
#pragma unroll
        for (int a = 0; a < 2; ++a)
#pragma unroll
            for (int b = 0; b < 2; ++b)
#pragma unroll
                for (int m = 0; m < 4; ++m)
#pragma unroll
                    for (int n = 0; n < 2; ++n) { if constexpr (GATHER || FP8) acc[a][b][m][n] = *(const volatile PG8_LAS f32x4*)(lds + 158784);
                        else acc[a][b][m][n] = (f32x4){0.f, 0.f, 0.f, 0.f}; }
        cur = nxt; cA = nA; cB = nB; ++ui;
        if constexpr (GATHER) {
#pragma unroll
            for (int h = 0; h < 2; ++h)
#pragma unroll
                for (int i = 0; i < 2; ++i) gc[h][i] = PG8_GOFF(ui, h, i);
        }
        if constexpr (ALIGN_EPI) { if (wr == 1) PG8_BAR; }
    }
    PG8_WAIT_V(0);
    if constexpr (!ALIGN_EPI) { if (wr == 0) PG8_BAR; }
    PG8_BAR;
#undef PG8_SA
#undef PG8_SB
#undef PG8_STAGE
#undef PG8_STAGE_A
#undef PG8_LDA
#undef PG8_LDB
#undef PG8_MMA
#undef PG8_ITER
#undef PG8_WAIT_V
#undef PG8_WAIT_L
#undef PG8_BAR
#undef PG8_SCHED
}
}

#define LAS __attribute__((address_space(3)))
typedef unsigned short bf16;
typedef unsigned v4u __attribute__((ext_vector_type(4)));
typedef unsigned v2u __attribute__((ext_vector_type(2)));
typedef float f32x4 __attribute__((ext_vector_type(4)));
typedef short bf16x8 __attribute__((ext_vector_type(8)));
#define LDS_WAIT() asm volatile("s_waitcnt lgkmcnt(0)" ::: "memory")
#define VM_WAIT() asm volatile("s_waitcnt vmcnt(0)" ::: "memory")
__device__ __forceinline__ unsigned f2bf(float f) { unsigned u = __builtin_bit_cast(unsigned, f); return (u + 0x7fffu + ((u >> 16) & 1u)) >> 16; }
__device__ __forceinline__ unsigned pk2(float lo, float hi) { return f2bf(lo) | (f2bf(hi) << 16); }
typedef __bf16 bf16x2_t __attribute__((ext_vector_type(2)));
__device__ __forceinline__ unsigned cvt2bf(float lo, float hi) { bf16x2_t v; v.x = (__bf16)lo; v.y = (__bf16)hi; return __builtin_bit_cast(unsigned, v); }
__device__ __forceinline__ float bf_lo(unsigned w) { return __builtin_bit_cast(float, w << 16); }
__device__ __forceinline__ float bf_hi(unsigned w) { return __builtin_bit_cast(float, w & 0xffff0000u); }
__device__ __forceinline__ float fp8c(float x) { return __builtin_amdgcn_fmed3f(x, -448.0f, 448.0f); }
__device__ __forceinline__ float wave_sum(float v) {
#pragma unroll
    for (int o = 1; o < 64; o <<= 1) v += __shfl_xor(v, o);
    return v;
}

#define XB_TMO      128
#define XB_XCNT(j)  (256  + 64 * (j))
#define XB_XSUB(j)  (1280 + 64 * (j))
#define XB_XGEN(j)  (2304 + 64 * (j))
#define XB_TOP      3328
#define XB_TOPGEN   3392
#define XCD_BAR_WORDS 3456
#define XB_SPIN_CAP (1u << 22)

__device__ __forceinline__ unsigned xb_ld(unsigned* p)              { return __hip_atomic_load(p, __ATOMIC_RELAXED, __HIP_MEMORY_SCOPE_AGENT); }
__device__ __forceinline__ unsigned xb_add(unsigned* p, unsigned v) { return __hip_atomic_fetch_add(p, v, __ATOMIC_RELAXED, __HIP_MEMORY_SCOPE_AGENT); }
__device__ __forceinline__ unsigned xb_xcc_id() { return (unsigned)__builtin_amdgcn_s_getreg((3 << 11) | 20) & 0xFu; }
#define XB_SPIN(cond, bar) do { unsigned _sp = 0; while (cond) { __builtin_amdgcn_s_sleep(1); \
    if ((++_sp & 255u) == 0u) { if (xb_ld(&(bar)[XB_TMO])) break; if (_sp > XB_SPIN_CAP) { atomicAdd(&(bar)[XB_TMO], 1u); break; } } } } while (0)

struct XcdBarrier { unsigned* bar; unsigned x; volatile LAS unsigned* st; bool t0; };

__device__ __forceinline__ XcdBarrier xcd_barrier_post(unsigned* bar, volatile LAS unsigned* st) {
    XcdBarrier b; b.bar = bar; b.x = xb_xcc_id(); b.st = st; b.t0 = threadIdx.x == 0;
    if (b.t0) (void)xb_add(&bar[XB_XCNT(b.x)], 1u);
    return b;
}
__device__ __forceinline__ void xcd_barrier_complete(unsigned* bar, unsigned x, unsigned& nloc, unsigned& nx) {
    const unsigned G = gridDim.x * gridDim.y * gridDim.z;
    unsigned sum, cnt, mine, sp = 0u;
    for (;;) {
        sum = 0u; cnt = 0u; mine = 0u;
#pragma unroll
        for (unsigned j = 0; j < 16; ++j) { const unsigned c = xb_ld(&bar[XB_XCNT(j)]); sum += c; cnt += (c > 0u) ? 1u : 0u; mine = (j == x) ? c : mine; }
        if (sum == G) break;
        __builtin_amdgcn_s_sleep(1);
        if ((++sp & 255u) == 0u) { if (xb_ld(&bar[XB_TMO])) break; if (sp > XB_SPIN_CAP) { atomicAdd(&bar[XB_TMO], 1u); break; } }
    }
    nloc = mine > 0u ? mine : 1u; nx = cnt > 0u ? cnt : 1u;
}
__device__ __forceinline__ void xcd_barrier(const XcdBarrier& b) {
    asm volatile("s_waitcnt vmcnt(0)" ::: "memory");
    __syncthreads();
    if (b.t0) {
        unsigned* bar = b.bar;
        __builtin_amdgcn_s_waitcnt(0);
        unsigned nloc = b.st[0], nx = b.st[1];
        if (nloc == 0u) { xcd_barrier_complete(bar, b.x, nloc, nx); b.st[0] = nloc; b.st[1] = nx; }
        const unsigned old = xb_add(&bar[XB_XSUB(b.x)], 1u);
        const unsigned gen = old / nloc;
        if (old + 1u == (gen + 1u) * nloc) {
            __builtin_amdgcn_fence(__ATOMIC_RELEASE, "agent");
            asm volatile("s_waitcnt vmcnt(0)" ::: "memory");
            const unsigned og = xb_add(&bar[XB_TOP], 1u);
            const unsigned tg = og / nx;
            if (og + 1u == (tg + 1u) * nx) xb_add(&bar[XB_TOPGEN], 1u);
            else XB_SPIN(xb_ld(&bar[XB_TOPGEN]) == tg, bar);
            __builtin_amdgcn_fence(__ATOMIC_ACQUIRE, "agent");
            xb_add(&bar[XB_XGEN(b.x)], 1u);
            asm volatile("s_waitcnt vmcnt(0)" ::: "memory");
        } else {
            XB_SPIN(xb_ld(&bar[XB_XGEN(b.x)]) == gen, bar);
            __builtin_amdgcn_fence(__ATOMIC_ACQUIRE, "agent");
            asm volatile("s_waitcnt vmcnt(0)" ::: "memory");
        }
    }
    __syncthreads();
}

constexpr int NWAVES = 8;
constexpr int D = 1024, NT = 49152, NP = 32768, TSEQ = 2048, NB = 24, NBP = 16;
constexpr int NE = 16, FF = 2048, CAP_P = 4096, CAP_S = 2048, NSLOT = 98304, SLOT_S0 = 65536;
constexpr int NHEAD = 16, HD = 64;
constexpr float EPS = 1e-6f;

constexpr size_t MiB = 1u << 20;
constexpr size_t WS_CTL = 0, CTL_ZERO_BYTES = 64 * 1024;
constexpr size_t WS_MOD = 1 * MiB;
constexpr size_t WS_SHIFT = 2 * MiB + 512 * 1024;
constexpr size_t WS_RPT = 2 * MiB + 576 * 1024;
constexpr size_t WS_IDX = 3 * MiB;
constexpr size_t WS_AFF = 4 * MiB;
constexpr size_t WS_SMAP = 7 * MiB;
constexpr size_t WS_BTQK = 10 * MiB;
constexpr size_t WS_BTV = 14 * MiB;
constexpr size_t WS_BTO = 16 * MiB;
constexpr size_t WS_BTIN = 18 * MiB;
constexpr size_t WS_V128 = 20 * MiB;
constexpr size_t WS_F128 = 21 * MiB;
constexpr size_t WS_WN = 21 * MiB + 896 * 1024;
constexpr size_t WS_BTOUT = 22 * MiB;
constexpr size_t WS_CS = 24 * MiB;
constexpr size_t WS_BT1 = 40 * MiB;
constexpr size_t WS_BT2 = 168 * MiB;
constexpr size_t WS_H = 232 * MiB;
constexpr size_t WS_S = 328 * MiB;
constexpr size_t WS_Q = WS_S, WS_K = WS_S + 96 * MiB, WS_VT = WS_S + 192 * MiB;
constexpr size_t WS_XE = WS_S, WS_Y = WS_S, WS_ACT = WS_S + 192 * MiB;
constexpr size_t WS_XB = WS_S + 384 * MiB;
constexpr size_t WS_VT2 = WS_S;
constexpr size_t WS_END = WS_S + 576 * MiB;
constexpr int CW_BAR = 1024;

constexpr int RING_BYTES = 131072;
constexpr int LDS_BYTES = 159744;
constexpr int MISC_OFF = 158720;
static_assert(MISC_OFF + 64 == 158784, "gemm_phase reads its 16 zero bytes at MISC_OFF + 64");

struct Args {
    const float* in[19]; float* out; unsigned char* ws; int ph_lo, ph_hi, use_bar, pad;
};

struct Ctx {
    LAS unsigned char* lds; int tid, lane, wave, G, blk;
    const float *in_xp, *in_xs, *in_cp, *in_cs, *in_norm1, *in_norm2, *in_adaw, *in_adab, *in_wqkv, *in_qg, *in_kg, *in_rpb, *in_wo, *in_win, *in_wout, *in_router, *in_gate, *in_up, *in_down;
    float* out; unsigned char* ws;
};

__device__ __forceinline__ void transpose_item(const float* W, int ldw, int k0, int n0, bf16* dst, int ldd, LAS float* scr, int lane) {
#pragma unroll 8
    for (int i = 0; i < 32; ++i) { const int kk = 2 * i + (lane >> 5); scr[kk * 33 + (lane & 31)] = W[(size_t)(k0 + kk) * ldw + n0 + (lane & 31)]; }
    LDS_WAIT(); asm volatile("" ::: "memory");
    const int c = lane & 7;
#pragma unroll
    for (int j = 0; j < 4; ++j) { const int n = (lane >> 3) + 8 * j; const LAS float* s = scr + (8 * c) * 33 + n;
        v4u o; o.x = pk2(s[0 * 33], s[1 * 33]); o.y = pk2(s[2 * 33], s[3 * 33]); o.z = pk2(s[4 * 33], s[5 * 33]); o.w = pk2(s[6 * 33], s[7 * 33]);
        *(v4u*)(dst + (size_t)n * ldd + k0 + 8 * c) = o; }
    LDS_WAIT(); asm volatile("" ::: "memory");
}

__device__ __forceinline__ const float* c_row(const Ctx& C, int b) { return b < NBP ? C.in_cp + (size_t)b * D : C.in_cs + (size_t)(b - NBP) * D; }
__device__ __forceinline__ float silu_f(float x) { return x / (1.0f + __expf(-x)); }

__device__ __forceinline__ void p0_prologue(const Ctx& C) {
    const int tid = C.tid, lane = C.lane, wave = C.wave, blk = C.blk;
    float* modv = (float*)(C.ws + WS_MOD);
    if (blk < 192) {
        const int l = blk / 96, jc = blk % 96;
        LAS float* sc = (LAS float*)C.lds;
        LAS float* red = (LAS float*)(C.lds + 98304);
        for (int i0 = tid; i0 < NB * D; i0 += 512 * 8) { float cv[8];
#pragma unroll
            for (int u = 0; u < 8; ++u) { const int i = i0 + 512 * u; cv[u] = c_row(C, i >> 10)[i & 1023]; }
#pragma unroll
            for (int u = 0; u < 8; ++u) sc[i0 + 512 * u] = silu_f(cv[u]); }
        __syncthreads();
        const float* W = C.in_adaw + (size_t)l * D * 6144 + jc * 64 + lane;
        float acc[NB];
#pragma unroll
        for (int b = 0; b < NB; ++b) acc[b] = 0.f;
        for (int k16 = wave * 128; k16 < wave * 128 + 128; k16 += 16) {
            float w[16];
#pragma unroll
            for (int q = 0; q < 16; ++q) w[q] = W[(size_t)(k16 + q) * 6144];
#pragma unroll
            for (int q4 = 0; q4 < 4; ++q4)
#pragma unroll
                for (int b = 0; b < NB; ++b) { const f32x4 s = *(const LAS f32x4*)(sc + b * 1024 + k16 + 4 * q4); acc[b] += s.x * w[4 * q4] + s.y * w[4 * q4 + 1] + s.z * w[4 * q4 + 2] + s.w * w[4 * q4 + 3]; }
        }
#pragma unroll
        for (int b = 0; b < NB; ++b) red[(wave * NB + b) * 64 + lane] = acc[b];
        __syncthreads();
        for (int i = tid; i < NB * 64; i += 512) { const int b = i >> 6, j = i & 63; float s = 0.f;
#pragma unroll
            for (int w = 0; w < 8; ++w) s += red[(w * NB + b) * 64 + j];
            modv[((size_t)l * NB + b) * 6144 + jc * 64 + j] = s + C.in_adab[l * 6144 + jc * 64 + j]; }
        __syncthreads();
    }
}
__device__ __forceinline__ void transpose_fp8_item(const float* W, int ldw, int k0, int n0, unsigned char* dst, int ldd, LAS unsigned char* scr, int lane, float scale);
__device__ __forceinline__ void p0_rest(const Ctx& C) {
    const int tid = C.tid, lane = C.lane, wave = C.wave, blk = C.blk;
    {
        const int kt = blk >> 4, g = (blk >> 2) & 3, kq = blk & 3;
        LAS float* wt = (LAS float*)C.lds;
        LAS float* twc = (LAS float*)(C.lds + 64 * 257 * 4);
        LAS float* tws = twc + 256;
        const float* Win = C.in_win;
        for (int i0 = tid; i0 < 64 * 256; i0 += 512 * 8) { float wv[8];
#pragma unroll
            for (int u = 0; u < 8; ++u) { const int i = i0 + 512 * u; wv[u] = Win[(size_t)(kt * 64 + (i >> 8)) * D + g * 256 + (i & 255)]; }
#pragma unroll
            for (int u = 0; u < 8; ++u) { const int i = i0 + 512 * u; wt[(i >> 8) * 257 + (i & 255)] = wv[u]; } }
        if (tid < 256) { float s, c; sincospif((float)tid * (1.0f / 128.0f), &s, &c); twc[tid] = c * 0.0625f; tws[tid] = s * 0.0625f; }
        __syncthreads();
        const int kk = tid & 63, k2b = kq * 32 + wave * 4;
        float ar[4], ai[4];
#pragma unroll
        for (int q = 0; q < 4; ++q) { ar[q] = 0.f; ai[q] = 0.f; }
        float an = 0.f;
#pragma unroll 4
        for (int c = 0; c < 256; ++c) {
            const float w = wt[kk * 257 + c];
            an += (c & 1) ? -w : w;
#pragma unroll
            for (int q = 0; q < 4; ++q) { const int m = ((k2b + q) * c) & 255; ar[q] += w * twc[m]; ai[q] -= w * tws[m]; }
        }
        bf16* Bt = (bf16*)(C.ws + WS_BTIN);
#pragma unroll
        for (int q = 0; q < 4; ++q) {
            const int vc = g * 128 + k2b + q;
            Bt[(size_t)vc * D + kt * 64 + kk] = (bf16)f2bf(ar[q]);
            Bt[(size_t)(512 + vc) * D + kt * 64 + kk] = (bf16)f2bf(ai[q]);
        }
        if (kq == 0 && wave == 0) ((float*)(C.ws + WS_WN))[g * D + kt * 64 + kk] = an * 0.0625f;
        __syncthreads();
    }
    for (int i = blk * 512 + tid; i < NHEAD * 3840; i += C.G * 512) { const int h = i / 3840, r = i - h * 3840, k = r & 63, drow = (r >> 6) % 15, sft = r / 960; int dc = k + sft - 16; dc = dc < 0 ? 0 : (dc > 30 ? 30 : dc);
        ((float*)(C.ws + WS_RPT))[i] = C.in_rpb[h * 465 + drow * 31 + dc] * 1.4426950408889634f; }
    if (blk == 255 && wave == 7) {
        float gq = fabsf(C.in_qg[lane]), gk = fabsf(C.in_kg[lane]), bm = 0.f;
        for (int i0 = lane; i0 < NHEAD * 465; i0 += 64 * 8) { float rv[8];
#pragma unroll
            for (int u = 0; u < 8; ++u) { const int i = i0 + 64 * u; rv[u] = i < NHEAD * 465 ? fabsf(C.in_rpb[i]) : 0.f; }
#pragma unroll
            for (int u = 0; u < 8; ++u) bm = fmaxf(bm, rv[u]); }
#pragma unroll
        for (int o = 1; o < 64; o <<= 1) { gq = fmaxf(gq, __shfl_xor(gq, o)); gk = fmaxf(gk, __shfl_xor(gk, o)); bm = fmaxf(bm, __shfl_xor(bm, o)); }
        if (lane == 0) *(float*)(C.ws + WS_SHIFT) = 8.0f * 1.03f * gq * gk + bm;
    }
    {
        LAS float* scr = (LAS float*)(C.lds + wave * 16384);
        const int gw = blk * NWAVES + wave, NGW = C.G * NWAVES;
        constexpr int I_QKV = 8 * 96, I_O = 16 * 32, I_OUT = 16 * 32, I_CS = 1024;
        for (int it = gw; it < I_QKV + I_O + I_OUT + I_CS; it += NGW) {
            int r = it;
            if (r < I_QKV) {
                const int kb = r / 96, nb = r % 96, n0 = nb * 32;
                if (n0 < 2048) {
                    const int sec = n0 >> 10, head = (n0 >> 6) & 15, d0 = n0 & 63;
                    const int row = 256 * (sec * 4 + (head >> 2)) + 128 * (d0 >> 5) + 32 * (head & 3);
                    transpose_fp8_item(C.in_wqkv, 3072, kb * 128, n0, C.ws + WS_BTQK + (size_t)row * D, D, (LAS unsigned char*)scr, lane, 32.0f);
                } else transpose_fp8_item(C.in_wqkv, 3072, kb * 128, n0, C.ws + WS_BTV + (size_t)(n0 - 2048) * D, D, (LAS unsigned char*)scr, lane, 32.0f);
                continue; }
            r -= I_QKV;
            if (r < I_O) { const int kb = r / 32, nb = r % 32; transpose_item(C.in_wo, D, kb * 64, nb * 32, (bf16*)(C.ws + WS_BTO) + (size_t)(nb * 32) * D, D, scr, lane); continue; }
            r -= I_O;
            if (r < I_OUT) {
                const int kb = r / 32, nb = r % 32, kk0 = kb * 64, n0 = nb * 32, part = kk0 >> 9, g = (kk0 >> 7) & 3, k20 = kk0 & 127;
                const float* W = C.in_wout;
#pragma unroll 8
                for (int i = 0; i < 32; ++i) { const int kl = 2 * i + (lane >> 5), k2 = k20 + kl, n = n0 + (lane & 31);
                    const float t1 = W[(size_t)(g * 256 + k2) * D + n], t2 = W[(size_t)(g * 256 + (k2 ? 256 - k2 : 128)) * D + n];
                    scr[kl * 33 + (lane & 31)] = part == 0 ? (k2 ? t1 + t2 : t1) : (k2 ? t1 - t2 : t2); }
                LDS_WAIT(); asm volatile("" ::: "memory");
                const int c = lane & 7; bf16* dst = (bf16*)(C.ws + WS_BTOUT) + (size_t)n0 * D;
#pragma unroll
                for (int j = 0; j < 4; ++j) { const int n = (lane >> 3) + 8 * j; const LAS float* s = scr + (8 * c) * 33 + n;
                    v4u o; o.x = pk2(s[0 * 33], s[1 * 33]); o.y = pk2(s[2 * 33], s[3 * 33]); o.z = pk2(s[4 * 33], s[5 * 33]); o.w = pk2(s[6 * 33], s[7 * 33]);
                    *(v4u*)(dst + (size_t)n * D + kk0 + 8 * c) = o; }
                LDS_WAIT(); asm volatile("" ::: "memory");
                continue; }
            r -= I_OUT;
            {
                const int k1 = r; bf16* cs = (bf16*)(C.ws + WS_CS);
                const float sc = 0.022097086912079608f;
#pragma unroll 2
                for (int ch = 0; ch < 4; ++ch) {
                    const int t0 = ch * 512 + lane * 8, part = t0 >> 10; float v[8];
#pragma unroll
                    for (int e = 0; e < 8; ++e) { const int t = (t0 & 1023) + e; const int p = (k1 * t) & 2047; float s, c; sincospif((float)p * (1.0f / 1024.0f), &s, &c); v[e] = (part ? s : c) * sc; }
                    v4u o; o.x = pk2(v[0], v[1]); o.y = pk2(v[2], v[3]); o.z = pk2(v[4], v[5]); o.w = pk2(v[6], v[7]);
                    *(v4u*)(cs + ((size_t)((part * 2 + (k1 & 1)) * 512 + (k1 >> 1)) * 1024 + (t0 & 1023))) = o;
                }
            }
        }
    }
}

#define COLJ(j, lane) ((((j) >> 1) << 9) + 8 * (lane) + (((j) & 1) << 2))
struct RowMod { f32x4 a[4], b[4]; int bcur; };
__device__ __forceinline__ void load_rowmod(RowMod& M, const float* modl  , const float* gain, int b, int slot_sh, int lane) {
    const float* mb = modl + (size_t)b * 6144;
#pragma unroll
    for (int j = 0; j < 4; ++j) { const int col = COLJ(j, lane);
        const f32x4 g = *(const f32x4*)(gain + col), sc = *(const f32x4*)(mb + (slot_sh + 1) * 1024 + col), sh = *(const f32x4*)(mb + slot_sh * 1024 + col);
        M.a[j] = g * (sc + 1.0f); M.b[j] = sh; }
    M.bcur = b;
}

__device__ __forceinline__ void store_row_bf16(bf16* orow, const f32x4 (&o)[4], int lane) {
#pragma unroll
    for (int jp = 0; jp < 2; ++jp) { v4u w; w.x = cvt2bf(o[2 * jp].x, o[2 * jp].y); w.y = cvt2bf(o[2 * jp].z, o[2 * jp].w); w.z = cvt2bf(o[2 * jp + 1].x, o[2 * jp + 1].y); w.w = cvt2bf(o[2 * jp + 1].z, o[2 * jp + 1].w); *(v4u*)(orow + 512 * jp + 8 * lane) = w; }
}

__device__ __forceinline__ void load_row_bf16(const bf16* row, f32x4 (&v)[4], int lane) {
#pragma unroll
    for (int jp = 0; jp < 2; ++jp) { const v4u w = *(const v4u*)(row + 512 * jp + 8 * lane);
        v[2 * jp] = (f32x4){bf_lo(w.x), bf_hi(w.x), bf_lo(w.y), bf_hi(w.y)}; v[2 * jp + 1] = (f32x4){bf_lo(w.z), bf_hi(w.z), bf_lo(w.w), bf_hi(w.w)}; }
}
constexpr int TB = 4, TOK_PER_BLK = NT / 256, TOK_PER_WAVE = TOK_PER_BLK / NWAVES;
__device__ __forceinline__ void sumsq4(const f32x4 (&v)[TB][4], float (&rinv)[TB]) {
    float ss[TB];
#pragma unroll
    for (int q = 0; q < TB; ++q) { ss[q] = 0.f;
#pragma unroll
        for (int j = 0; j < 4; ++j) ss[q] += (v[q][j].x * v[q][j].x + v[q][j].y * v[q][j].y) + (v[q][j].z * v[q][j].z + v[q][j].w * v[q][j].w); }
#pragma unroll
    for (int o = 1; o < 64; o <<= 1)
#pragma unroll
        for (int q = 0; q < TB; ++q) ss[q] += __shfl_xor(ss[q], o);
#pragma unroll
    for (int q = 0; q < TB; ++q) rinv[q] = 1.0f / sqrtf(ss[q] * (1.0f / D) + EPS);
}
__device__ __forceinline__ void norm_rows_phase(const Ctx& C) {
    const float* modl = (const float*)(C.ws + WS_MOD);
    const float* gain = C.in_norm1;
    unsigned char* H8 = C.ws + WS_H;
    RowMod M; M.bcur = -1;
    const int lane = C.lane;
    for (int i = 0; i < TOK_PER_WAVE / TB; ++i) {
        const int tokb = C.blk * TOK_PER_BLK + C.wave * TOK_PER_WAVE + TB * i, b = tokb >> 11;
        if (b != M.bcur) load_rowmod(M, modl, gain, b, 0, lane);
        const float* xr = tokb < NP ? C.in_xp + (size_t)tokb * D : C.in_xs + (size_t)(tokb - NP) * D;
        f32x4 v[TB][4]; float rinv[TB];
#pragma unroll
        for (int q = 0; q < TB; ++q)
#pragma unroll
            for (int j = 0; j < 4; ++j) v[q][j] = __builtin_nontemporal_load((const f32x4*)(xr + q * D + COLJ(j, lane)));
        sumsq4(v, rinv);
#pragma unroll
        for (int q = 0; q < TB; ++q) {
#pragma unroll
            for (int j = 0; j < 4; ++j) v[q][j] = v[q][j] * rinv[q] * M.a[j] + M.b[j];
#pragma unroll
            for (int jp = 0; jp < 2; ++jp) { int w0 = 0, w1 = 0;
                w0 = __builtin_amdgcn_cvt_pk_fp8_f32(fp8c(v[q][2 * jp].x), fp8c(v[q][2 * jp].y), w0, false); w0 = __builtin_amdgcn_cvt_pk_fp8_f32(fp8c(v[q][2 * jp].z), fp8c(v[q][2 * jp].w), w0, true);
                w1 = __builtin_amdgcn_cvt_pk_fp8_f32(fp8c(v[q][2 * jp + 1].x), fp8c(v[q][2 * jp + 1].y), w1, false); w1 = __builtin_amdgcn_cvt_pk_fp8_f32(fp8c(v[q][2 * jp + 1].z), fp8c(v[q][2 * jp + 1].w), w1, true);
                v2u w; w.x = (unsigned)w0; w.y = (unsigned)w1; *(v2u*)(H8 + (size_t)(tokb + q) * D + 512 * jp + 8 * lane) = w; }
        }
    }
}

__device__ __forceinline__ void norm_router_phase(const Ctx& C, int layer) {
    LAS float* wrT = (LAS float*)C.lds;
    const float* wr = C.in_router + (size_t)layer * D * NE;
    for (int i0 = C.tid; i0 < D * NE / 4; i0 += 512 * 8) { f32x4 wv[8];
#pragma unroll
        for (int u = 0; u < 8; ++u) wv[u] = *(const f32x4*)(wr + 4 * (i0 + 512 * u));
#pragma unroll
        for (int u = 0; u < 8; ++u) { const int i = i0 + 512 * u, col = i >> 2, e0 = (i & 3) * 4; const f32x4 w = wv[u];
            wrT[(e0 + 0) * D + col] = w.x; wrT[(e0 + 1) * D + col] = w.y; wrT[(e0 + 2) * D + col] = w.z; wrT[(e0 + 3) * D + col] = w.w; } }
    __syncthreads();
    const float* modl = (const float*)(C.ws + WS_MOD) + (size_t)layer * NB * 6144;
    const float* gain = C.in_norm2 + layer * D;
    unsigned char* H8 = C.ws + WS_H;
    float* aff = (float*)(C.ws + WS_AFF);
    RowMod M; M.bcur = -1;
    const int lane = C.lane;
    for (int i = 0; i < TOK_PER_WAVE / TB; ++i) {
        const int tokb = C.blk * TOK_PER_BLK + C.wave * TOK_PER_WAVE + TB * i, b = tokb >> 11;
        if (b != M.bcur) load_rowmod(M, modl, gain, b, 3, lane);
        const bf16* xr = (const bf16*)(C.ws + WS_XB) + (size_t)tokb * D;
        f32x4 v[TB][4]; float rinv[TB];
#pragma unroll
        for (int q = 0; q < TB; ++q) load_row_bf16(xr + q * D, v[q], lane);
        sumsq4(v, rinv);
#pragma unroll
        for (int q = 0; q < TB; ++q) {
#pragma unroll
            for (int j = 0; j < 4; ++j) v[q][j] = v[q][j] * rinv[q] * M.a[j] + M.b[j];
#pragma unroll
            for (int jp = 0; jp < 2; ++jp) { int w0 = 0, w1 = 0;
                w0 = __builtin_amdgcn_cvt_pk_fp8_f32(fp8c(v[q][2 * jp].x), fp8c(v[q][2 * jp].y), w0, false); w0 = __builtin_amdgcn_cvt_pk_fp8_f32(fp8c(v[q][2 * jp].z), fp8c(v[q][2 * jp].w), w0, true);
                w1 = __builtin_amdgcn_cvt_pk_fp8_f32(fp8c(v[q][2 * jp + 1].x), fp8c(v[q][2 * jp + 1].y), w1, false); w1 = __builtin_amdgcn_cvt_pk_fp8_f32(fp8c(v[q][2 * jp + 1].z), fp8c(v[q][2 * jp + 1].w), w1, true);
                v2u w; w.x = (unsigned)w0; w.y = (unsigned)w1; *(v2u*)(H8 + (size_t)(tokb + q) * D + 512 * jp + 8 * lane) = w; }
        }
        float p[TB][16];
#pragma unroll
        for (int e = 0; e < 16; ++e) {
            f32x4 w[4];
#pragma unroll
            for (int j = 0; j < 4; ++j) w[j] = *(const LAS f32x4*)(wrT + e * D + COLJ(j, lane));
#pragma unroll
            for (int q = 0; q < TB; ++q) { f32x4 P = v[q][0] * w[0];
#pragma unroll
                for (int j = 1; j < 4; ++j) P = v[q][j] * w[j] + P;
                p[q][e] = (P.x + P.y) + (P.z + P.w); }
            if ((e & 3) == 3) asm volatile("" : "+v"(p[0][e]), "+v"(p[1][e]), "+v"(p[2][e]), "+v"(p[3][e]) :: "memory");
        }
        float q8[TB][8], q4[TB][4], q2[TB][2], q1[TB];
        { const bool hi = (lane & 32) != 0;
#pragma unroll
          for (int k = 0; k < 8; ++k)
#pragma unroll
              for (int q = 0; q < TB; ++q) { const float keep = hi ? p[q][k + 8] : p[q][k], send = hi ? p[q][k] : p[q][k + 8]; q8[q][k] = keep + __shfl_xor(send, 32); } }
        { const bool hi = (lane & 16) != 0;
#pragma unroll
          for (int k = 0; k < 4; ++k)
#pragma unroll
              for (int q = 0; q < TB; ++q) { const float keep = hi ? q8[q][k + 4] : q8[q][k], send = hi ? q8[q][k] : q8[q][k + 4]; q4[q][k] = keep + __shfl_xor(send, 16); } }
        { const bool hi = (lane & 8) != 0;
#pragma unroll
          for (int k = 0; k < 2; ++k)
#pragma unroll
              for (int q = 0; q < TB; ++q) { const float keep = hi ? q4[q][k + 2] : q4[q][k], send = hi ? q4[q][k] : q4[q][k + 2]; q2[q][k] = keep + __shfl_xor(send, 8); } }
        { const bool hi = (lane & 4) != 0;
#pragma unroll
          for (int q = 0; q < TB; ++q) { const float keep = hi ? q2[q][1] : q2[q][0], send = hi ? q2[q][0] : q2[q][1]; q1[q] = keep + __shfl_xor(send, 4); } }
#pragma unroll
        for (int q = 0; q < TB; ++q) q1[q] += __shfl_xor(q1[q], 2);
#pragma unroll
        for (int q = 0; q < TB; ++q) q1[q] += __shfl_xor(q1[q], 1);
        float mx[TB], ex[TB], sm[TB];
#pragma unroll
        for (int q = 0; q < TB; ++q) mx[q] = q1[q];
#pragma unroll
        for (int o = 4; o < 64; o <<= 1)
#pragma unroll
            for (int q = 0; q < TB; ++q) mx[q] = fmaxf(mx[q], __shfl_xor(mx[q], o));
#pragma unroll
        for (int q = 0; q < TB; ++q) { ex[q] = expf(q1[q] - mx[q]); sm[q] = ex[q]; }
#pragma unroll
        for (int o = 4; o < 64; o <<= 1)
#pragma unroll
            for (int q = 0; q < TB; ++q) sm[q] += __shfl_xor(sm[q], o);
        if ((lane & 3) == 0) {
#pragma unroll
            for (int q = 0; q < TB; ++q) aff[(size_t)(tokb + q) * NE + (lane >> 2)] = ex[q] / sm[q];
        }
    }
}

__device__ __forceinline__ void norm_router_mfma_phase(const Ctx& C, int layer) {
    const float* wr = C.in_router + (size_t)layer * D * NE;
    const float* modl = (const float*)(C.ws + WS_MOD) + (size_t)layer * NB * 6144;
    const float* gain = C.in_norm2 + layer * D;
    const int tok0 = C.blk * TOK_PER_BLK, b0 = tok0 >> 11, b1 = (tok0 + TOK_PER_BLK - 1) >> 11, lane = C.lane;
    LAS unsigned char* wP = C.lds; LAS float* ta = (LAS float*)(C.lds + 98304); LAS float* tb = ta + 1024; LAS float* tc = tb + 1024; LAS float* red = tc + 16;
    unsigned char* H8 = C.ws + WS_H;
    float* aff = (float*)(C.ws + WS_AFF);
#pragma nounroll
    for (int sidx = 0; sidx < 2; ++sidx) {
        if (sidx == 1 && b1 == b0) break;
        const int b = sidx ? b1 : b0;
        int lane_ = lane; asm volatile("" : "+v"(lane_));
        const int t = lane_ & 15, kq = lane_ >> 4; int tid_ = C.tid; asm volatile("" : "+v"(tid_));
        const int ix16 = (lane_ ^ 16) << 2, ix32 = (lane_ ^ 32) << 2;
#define RX(v, ix) __builtin_bit_cast(float, __builtin_amdgcn_ds_bpermute((ix), __builtin_bit_cast(int, (v))))
        if (sidx == 1) __syncthreads();
        const float* mb = modl + (size_t)b * 6144;
        { float g[2], sc[2], sh[2];
#pragma unroll
          for (int u = 0; u < 2; ++u) { const int k = tid_ + 512 * u; g[u] = gain[k]; sc[u] = mb[4 * 1024 + k]; sh[u] = mb[3 * 1024 + k]; }
#pragma unroll
          for (int u = 0; u < 2; ++u) { const int k = tid_ + 512 * u; ta[k] = g[u] * (sc[u] + 1.0f); tb[k] = sh[u]; } }
        __syncthreads();
        {
            float wv[4][8], cp = 0.f;
            const float* wlane = wr + (size_t)(C.wave * 16 + kq) * 8 * NE + t; asm volatile("" : "+v"(wlane));
#pragma unroll
            for (int p = 0; p < 4; ++p)
#pragma unroll
                for (int i = 0; i < 8; ++i) wv[p][i] = wlane[(32 * p + i) * NE];
#pragma unroll
            for (int p = 0; p < 4; ++p) { const int k8 = (C.wave * 4 + p) * 4 + kq;
                const f32x4 a0 = *(const LAS f32x4*)(ta + 8 * k8), a1 = *(const LAS f32x4*)(ta + 8 * k8 + 4), s0 = *(const LAS f32x4*)(tb + 8 * k8), s1 = *(const LAS f32x4*)(tb + 8 * k8 + 4);
                const float av[8] = {a0.x, a0.y, a0.z, a0.w, a1.x, a1.y, a1.z, a1.w}, sv[8] = {s0.x, s0.y, s0.z, s0.w, s1.x, s1.y, s1.z, s1.w};
                unsigned h1[8], h2[8], h3[8];
#pragma unroll
                for (int i = 0; i < 8; ++i) { const float w = wv[p][i] * av[i]; cp += wv[p][i] * sv[i];
                    h1[i] = f2bf(w); const float r1 = w - __builtin_bit_cast(float, h1[i] << 16);
                    h2[i] = f2bf(r1); const float r2 = r1 - __builtin_bit_cast(float, h2[i] << 16);
                    h3[i] = f2bf(r2); }
                v4u o1, o2, o3;
                o1.x = h1[0] | (h1[1] << 16); o1.y = h1[2] | (h1[3] << 16); o1.z = h1[4] | (h1[5] << 16); o1.w = h1[6] | (h1[7] << 16);
                o2.x = h2[0] | (h2[1] << 16); o2.y = h2[2] | (h2[3] << 16); o2.z = h2[4] | (h2[5] << 16); o2.w = h2[6] | (h2[7] << 16);
                o3.x = h3[0] | (h3[1] << 16); o3.y = h3[2] | (h3[3] << 16); o3.z = h3[4] | (h3[5] << 16); o3.w = h3[6] | (h3[7] << 16);
                *(LAS v4u*)(wP + ((0 * 128 + k8) * 16 + t) * 16) = o1; *(LAS v4u*)(wP + ((1 * 128 + k8) * 16 + t) * 16) = o2; *(LAS v4u*)(wP + ((2 * 128 + k8) * 16 + t) * 16) = o3;
                asm volatile("" : "+v"(cp) :: "memory"); }
            cp += RX(cp, ix16); cp += RX(cp, ix32);
            if (kq == 0) red[C.wave * 16 + t] = cp;
        }
        __syncthreads();
        if (tid_ < 16) { float sacc = 0.f;
#pragma unroll
            for (int w = 0; w < NWAVES; ++w) sacc += red[w * 16 + tid_];
            tc[tid_] = sacc; }
        __syncthreads();
        for (int gi = C.wave; gi < TOK_PER_BLK / 16; gi += NWAVES) {
            const int tokg = tok0 + 16 * gi;
            if ((tokg >> 11) != b) continue;
            const bf16* xrow = (const bf16*)(C.ws + WS_XB) + (size_t)(tokg + t) * D + 16 * kq;
            v4u raw[16][2];
#pragma unroll
            for (int ch = 0; ch < 16; ++ch) { raw[ch][0] = *(const v4u*)(xrow + ch * 64); raw[ch][1] = *(const v4u*)(xrow + ch * 64 + 8); }
            f32x4 acc1 = (f32x4){0.f, 0.f, 0.f, 0.f}, acc2 = acc1, acc3 = acc1, accS = acc1;
            const LAS unsigned char* wl = wP + (2 * kq * 16 + t) * 16;
            bf16x8 W1 = *(const LAS bf16x8*)(wl), W2 = *(const LAS bf16x8*)(wl + 128 * 256), W3 = *(const LAS bf16x8*)(wl + 2 * 128 * 256);
#pragma unroll
            for (int st = 0; st < 32; ++st) {
                bf16x8 N1 = W1, N2 = W2, N3 = W3;
                if (st < 31) { const LAS unsigned char* wn = wl + (((st + 1) >> 1) * 8 + ((st + 1) & 1)) * 256; N1 = *(const LAS bf16x8*)(wn); N2 = *(const LAS bf16x8*)(wn + 128 * 256); N3 = *(const LAS bf16x8*)(wn + 2 * 128 * 256); }
                const bf16x8 xb = __builtin_bit_cast(bf16x8, raw[st >> 1][st & 1]);
                __builtin_amdgcn_sched_barrier(0);
                acc1 = __builtin_amdgcn_mfma_f32_16x16x32_bf16(W1, xb, acc1, 0, 0, 0);
                acc2 = __builtin_amdgcn_mfma_f32_16x16x32_bf16(W2, xb, acc2, 0, 0, 0);
                acc3 = __builtin_amdgcn_mfma_f32_16x16x32_bf16(W3, xb, acc3, 0, 0, 0);
                accS = __builtin_amdgcn_mfma_f32_16x16x32_bf16(xb, xb, accS, 0, 0, 0);
                W1 = N1; W2 = N2; W3 = N3;
            }
            const float dsel = (t & 2) ? ((t & 1) ? accS.w : accS.z) : ((t & 1) ? accS.y : accS.x);
            const float ss = RX(dsel, (t + 16 * (t >> 2)) << 2);
            const float rinv = 1.0f / sqrtf(ss * (1.0f / D) + EPS);
            const f32x4 cv = *(const LAS f32x4*)(tc + 4 * kq);
            f32x4 lg = ((acc3 + acc2) + acc1) * rinv + cv;
            float mx = fmaxf(fmaxf(lg.x, lg.y), fmaxf(lg.z, lg.w));
            mx = fmaxf(mx, RX(mx, ix16)); mx = fmaxf(mx, RX(mx, ix32));
            f32x4 ex; ex.x = expf(lg.x - mx); ex.y = expf(lg.y - mx); ex.z = expf(lg.z - mx); ex.w = expf(lg.w - mx);
            float sm = (ex.x + ex.y) + (ex.z + ex.w);
            sm += RX(sm, ix16); sm += RX(sm, ix32);
            *(f32x4*)(aff + (size_t)(tokg + t) * NE + 4 * kq) = ex / sm;
            unsigned char* hrow = H8 + (size_t)(tokg + t) * D + 16 * kq;
#pragma unroll
            for (int ch = 0; ch < 16; ++ch) {
                unsigned ow[4];
#pragma unroll
                for (int hf = 0; hf < 2; ++hf) {
                    v4u w = raw[ch][hf]; asm volatile("" : "+v"(w)); const int c0 = ch * 64 + 16 * kq + 8 * hf;
                    const f32x4 a0 = *(const LAS f32x4*)(ta + c0), a1 = *(const LAS f32x4*)(ta + c0 + 4), s0 = *(const LAS f32x4*)(tb + c0), s1 = *(const LAS f32x4*)(tb + c0 + 4);
                    const f32x4 x0 = (f32x4){bf_lo(w.x), bf_hi(w.x), bf_lo(w.y), bf_hi(w.y)}, x1 = (f32x4){bf_lo(w.z), bf_hi(w.z), bf_lo(w.w), bf_hi(w.w)};
                    const f32x4 h0 = x0 * rinv * a0 + s0, h1 = x1 * rinv * a1 + s1;
                    int w0 = 0, w1 = 0;
                    w0 = __builtin_amdgcn_cvt_pk_fp8_f32(fp8c(h0.x), fp8c(h0.y), w0, false); w0 = __builtin_amdgcn_cvt_pk_fp8_f32(fp8c(h0.z), fp8c(h0.w), w0, true);
                    w1 = __builtin_amdgcn_cvt_pk_fp8_f32(fp8c(h1.x), fp8c(h1.y), w1, false); w1 = __builtin_amdgcn_cvt_pk_fp8_f32(fp8c(h1.z), fp8c(h1.w), w1, true);
                    ow[2 * hf] = (unsigned)w0; ow[2 * hf + 1] = (unsigned)w1;
                }
                v4u o; o.x = ow[0]; o.y = ow[1]; o.z = ow[2]; o.w = ow[3]; *(v4u*)(hrow + ch * 64) = o;
            }
        }
    }
}
#undef RX

constexpr int AT_KPITCH = 128, AT_VPITCH = 1056, AT_VOFF = 16 * 32 * AT_KPITCH, AT_RPB = AT_VOFF + 64 * AT_VPITCH;
__device__ __forceinline__ int att_ksw(int key) { return ((key >> 1) * 3) & 7; }
struct AttItem { int b, h, j, r0, nlo, cnt, kc0; };
__device__ __forceinline__ AttItem att_item(int xcd, int ci, int n) {
    AttItem I; const int oct = n & 3, pair = xcd * 48 + 8 * (n >> 2) + (ci >> 2);
    I.j = ci & 3; I.h = pair & 15; I.b = pair >> 4; I.r0 = 8 * oct;
    I.nlo = oct == 0 ? 0 : 8 * oct + 3; I.cnt = oct == 0 ? 11 : (oct == 3 ? 5 : 8);
    int kc0 = 16 * I.j - 8; I.kc0 = kc0 < 0 ? 0 : (kc0 > 32 ? 32 : kc0); return I;
}
__device__ __forceinline__ void att_issue(const AttItem& I, const bf16* Q, const bf16* Kb, const bf16* VT, int tid, int wave, int lane, v4u (&kreg)[6], v4u (&vreg)[6], v4u (&qreg)[2]) {
    const size_t tok0 = (size_t)I.b * TSEQ + (size_t)I.nlo * 64 + I.kc0;
    const char* kbase = (const char*)(Kb + tok0 * D + I.h * HD);
    const char* vbase = (const char*)(VT + ((size_t)((I.b * NHEAD + I.h) * 32 + I.nlo) * 8 + (I.kc0 >> 3)) * 512);
    asm volatile("" : "+v"(tid));
#pragma unroll
    for (int u = 0; u < 6; ++u) {
        const int ci = tid + 512 * u, key = ci >> 3, chunk = ci & 7, krow = key >> 5, kcol = key & 31;
        if (krow < I.cnt) kreg[u] = *(const v4u*)(kbase + (unsigned)((krow * 64 + kcol) * (D * 2) + chunk * 16));
        const int d = ci & 63, vch = (ci >> 6) & 3, vr = ci >> 8;
        if (vr < I.cnt) vreg[u] = *(const v4u*)(vbase + (unsigned)(((vr * 8 + vch) * 64 + d) * 16));
    }
    const int fr = lane & 15, fq = lane >> 4;
    const size_t tokq = (size_t)I.b * TSEQ + (I.r0 + wave) * 64 + 16 * I.j + fr;
#pragma unroll
    for (int ks = 0; ks < 2; ++ks) qreg[ks] = *(const v4u*)(Q + tokq * D + I.h * HD + 32 * ks + 8 * fq);
}
__device__ __forceinline__ void att_fill(const AttItem& I, LAS unsigned char* lds, int tid, const v4u (&kreg)[6], const v4u (&vreg)[6]) {
    asm volatile("" : "+v"(tid));
#pragma unroll
    for (int u = 0; u < 6; ++u) {
        const int ci = tid + 512 * u, key = ci >> 3, chunk = ci & 7, krow = key >> 5, kcol = key & 31;
        if (krow < I.cnt) { const int sk = ((I.nlo + krow) & 15) * 32 + kcol; *(LAS v4u*)(lds + sk * AT_KPITCH + ((chunk ^ att_ksw(sk)) << 4)) = kreg[u]; }
        const int d = ci & 63, vch = (ci >> 6) & 3, vr = ci >> 8;
        if (vr < I.cnt) *(LAS v4u*)(lds + AT_VOFF + d * AT_VPITCH + ((I.nlo + vr) & 15) * 64 + vch * 16) = vreg[u];
    }
}
__device__ __forceinline__ void attn_phase(const Ctx& C) {
    const bf16* Q = (const bf16*)(C.ws + WS_Q); const bf16* Kb = (const bf16*)(C.ws + WS_K); const bf16* VT = (const bf16*)(C.ws + WS_VT);
    bf16* O = (bf16*)(C.ws + WS_H);
    const int tid = C.tid, lane = C.lane, wave = C.wave, fr = lane & 15, fq = lane >> 4;
    LAS unsigned char* lds = C.lds;
    LAS float* rp = (LAS float*)(lds + AT_RPB);
    const float shift = *(const float*)(C.ws + WS_SHIFT) * 1.4426950408889634f;
    constexpr int PER = 24;
    const int xcd_ = C.blk & 7, ci_ = C.blk >> 3;
    v4u kregA[6], vregA[6], qregA[2], kregB[6], vregB[6], qregB[2];
    { const AttItem I0 = att_item(xcd_, ci_, 0); att_issue(I0, Q, Kb, VT, tid, wave, lane, kregA, vregA, qregA); const AttItem I1 = att_item(xcd_, ci_, 1); att_issue(I1, Q, Kb, VT, tid, wave, lane, kregB, vregB, qregB); }
    int hcur = -1;
#define ATT_RROW(i) (((rs + (i)) & 15))
#define ATT_LDK(dst, i) do { const LAS unsigned char* kr_ = kp + ATT_RROW(i) * (32 * AT_KPITCH); dst[0] = *(const LAS bf16x8*)(kr_ + kc0_); dst[1] = *(const LAS bf16x8*)(kr_ + (kc0_ ^ 64)); dst[2] = *(const LAS bf16x8*)(kr_ + 4 * AT_KPITCH + kc1_); dst[3] = *(const LAS bf16x8*)(kr_ + 4 * AT_KPITCH + (kc1_ ^ 64)); } while (0)
#define ATT_STEP(NN, KR, VR, QR) do { \
 \
        const AttItem J = att_item(xcd_, ci_, NN); \
        att_fill(J, lds, tid, KR, VR); \
        if (J.h != hcur) { \
            const v4u* src = (const v4u*)(C.ws + WS_RPT) + (size_t)J.h * 960; \
            const v4u t0 = src[tid], t1 = tid < 448 ? src[tid + 512] : (v4u){0u, 0u, 0u, 0u}; \
            ((LAS v4u*)rp)[tid] = t0; if (tid < 448) ((LAS v4u*)rp)[tid + 512] = t1; \
            hcur = J.h; } \
        bf16x8 Qf[2]; Qf[0] = __builtin_bit_cast(bf16x8, QR[0]); Qf[1] = __builtin_bit_cast(bf16x8, QR[1]); \
        __syncthreads(); \
 \
        if (NN + 2 < PER) { const AttItem I2 = att_item(xcd_, ci_, NN + 2); att_issue(I2, Q, Kb, VT, tid, wave, lane, KR, VR, QR); } \
 \
        const int r = J.r0 + wave; int rs = r - 4; rs = rs < 0 ? 0 : (rs > 24 ? 24 : rs); \
        const int qc = 16 * J.j + fr; \
        int start = qc - 8; start = start < 0 ? 0 : (start > 48 ? 48 : start); \
        float msk[8]; \
        _Pragma("unroll") \
        for (int T = 0; T < 2; ++T) \
        _Pragma("unroll") \
            for (int jj = 0; jj < 4; ++jj) { const int rel = J.kc0 + 8 * fq + 4 * T + jj - start; msk[4 * T + jj] = ((unsigned)rel < 16u) ? -shift : -1e30f; } \
 \
        const int bi = 16 + J.kc0 + 8 * fq - qc + 15; \
        const LAS float* bp = rp + ((bi & 3) * 15 + (rs - r + 7)) * 64 + (bi & ~3); \
        const int key0 = 8 * (fr >> 2) + (fr & 3); \
        const LAS unsigned char* kp = lds + key0 * AT_KPITCH; \
        const int kc0_ = (fq ^ att_ksw(key0)) << 4, kc1_ = (fq ^ att_ksw(key0 + 4)) << 4; \
        const LAS unsigned char* vp = lds + AT_VOFF + fr * AT_VPITCH + 16 * fq; \
        f32x4 Oa[4]; float sum = 0.f; \
        _Pragma("unroll") \
        for (int dt = 0; dt < 4; ++dt) Oa[dt] = (f32x4){0.f, 0.f, 0.f, 0.f}; \
 \
        bf16x8 Kc[4], Kn[4]; f32x4 Bc[2], Bn[2]; \
        ATT_LDK(Kc, 0); \
        Bc[0] = *(const LAS f32x4*)(bp); Bc[1] = *(const LAS f32x4*)(bp + 4); \
        _Pragma("unroll") \
        for (int i8 = 0; i8 < 8; ++i8) { \
            if (i8 < 7) { ATT_LDK(Kn, i8 + 1); Bn[0] = *(const LAS f32x4*)(bp + (i8 + 1) * 64); Bn[1] = *(const LAS f32x4*)(bp + (i8 + 1) * 64 + 4); } \
            bf16x8 Vf[4]; \
        _Pragma("unroll") \
            for (int dt = 0; dt < 4; ++dt) Vf[dt] = *(const LAS bf16x8*)(vp + ATT_RROW(i8) * 64 + dt * 16 * AT_VPITCH); \
            f32x4 S[2]; \
        _Pragma("unroll") \
            for (int T = 0; T < 2; ++T) { \
                f32x4 sv = Bc[T] + (f32x4){msk[4 * T], msk[4 * T + 1], msk[4 * T + 2], msk[4 * T + 3]}; \
                sv = __builtin_amdgcn_mfma_f32_16x16x32_bf16(Kc[2 * T], Qf[0], sv, 0, 0, 0); \
                sv = __builtin_amdgcn_mfma_f32_16x16x32_bf16(Kc[2 * T + 1], Qf[1], sv, 0, 0, 0); \
                S[T] = sv; \
            } \
            float pv[8]; \
        _Pragma("unroll") \
            for (int T = 0; T < 2; ++T) \
        _Pragma("unroll") \
                for (int jj = 0; jj < 4; ++jj) { const float p = __builtin_amdgcn_exp2f(S[T][jj]); pv[4 * T + jj] = p; sum += p; } \
            v4u w; w.x = cvt2bf(pv[0], pv[1]); w.y = cvt2bf(pv[2], pv[3]); w.z = cvt2bf(pv[4], pv[5]); w.w = cvt2bf(pv[6], pv[7]); \
            const bf16x8 Pf = __builtin_bit_cast(bf16x8, w); \
        _Pragma("unroll") \
            for (int dt = 0; dt < 4; ++dt) Oa[dt] = __builtin_amdgcn_mfma_f32_16x16x32_bf16(Vf[dt], Pf, Oa[dt], 0, 0, 0); \
            if (i8 < 7) { \
        _Pragma("unroll") \
                for (int q = 0; q < 4; ++q) Kc[q] = Kn[q]; \
                Bc[0] = Bn[0]; Bc[1] = Bn[1]; \
            } \
        } \
        sum += __shfl_xor(sum, 16); sum += __shfl_xor(sum, 32); \
        const float inv = 1.0f / sum; \
        bf16* op = O + ((size_t)J.b * TSEQ + r * 64 + qc) * D + J.h * HD + 4 * fq; \
        _Pragma("unroll") \
        for (int dt = 0; dt < 4; ++dt) { v2u w; w.x = cvt2bf(Oa[dt][0] * inv, Oa[dt][1] * inv); w.y = cvt2bf(Oa[dt][2] * inv, Oa[dt][3] * inv); *(v2u*)(op + 16 * dt) = w; } \
        __syncthreads(); \
    } while (0)
    for (int n = 0; n < PER; n += 2) { ATT_STEP(n, kregA, vregA, qregA); ATT_STEP(n + 1, kregB, vregB, qregB); }
#undef ATT_STEP
#undef ATT_LDK
#undef ATT_RROW
}

__device__ __forceinline__ unsigned pidx(unsigned i) { return i + (i >> 6); }
__device__ __forceinline__ void select_bin(const LAS unsigned* hist, int nb, unsigned want, volatile LAS unsigned* res, int lane) {
    const int per = nb >> 6; unsigned s = 0;
    for (int k = 0; k < per; ++k) s += hist[lane * per + k];
    unsigned t = s;
#pragma unroll
    for (int o = 1; o < 64; o <<= 1) { const unsigned u = __shfl_down(t, o); if (lane + o < 64) t += u; }
    const unsigned above = t - s;
    if (above < want && want <= t) {
        unsigned a = above;
        for (int k = per - 1; k >= 0; --k) { const unsigned hh = hist[lane * per + k]; if (a + hh >= want) { res[0] = (unsigned)(lane * per + k); res[1] = a; break; } a += hh; }
    }
}
__device__ __forceinline__ void topk_block(const Ctx& C) {
    const int tid = C.tid, lane = C.lane, wave = C.wave;
    const int g = C.blk >> 4, e = C.blk & 15;
    const int n = g ? (NT - NP) : NP, cap = n >> 3, tok0 = g ? NP : 0, slot0 = g ? SLOT_S0 + e * CAP_S : e * CAP_P;
    LAS unsigned* keys = (LAS unsigned*)C.lds;
    LAS unsigned* hist = (LAS unsigned*)(C.lds + 133120);
    volatile LAS unsigned* res = (volatile LAS unsigned*)(C.lds + 141312);
    const float* aff = (const float*)(C.ws + WS_AFF);
    for (int i0 = tid; i0 < n; i0 += 512 * 8) { float av[8];
#pragma unroll
        for (int u = 0; u < 8; ++u) av[u] = aff[(size_t)(tok0 + i0 + 512 * u) * NE + e];
#pragma unroll
        for (int u = 0; u < 8; ++u) keys[pidx((unsigned)(i0 + 512 * u))] = __builtin_bit_cast(unsigned, av[u]); }
    for (int i = tid; i < 2048; i += 512) hist[i] = 0u;
    __syncthreads();
    for (int i = tid; i < n; i += 512) __hip_atomic_fetch_add(&hist[keys[pidx(i)] >> 21], 1u, __ATOMIC_RELAXED, __HIP_MEMORY_SCOPE_WORKGROUP);
    __syncthreads();
    if (wave == 0) select_bin(hist, 2048, (unsigned)cap, res, lane);
    __syncthreads();
    const unsigned binA = res[0]; unsigned want = (unsigned)cap - res[1];
    __syncthreads();
    for (int i = tid; i < 2048; i += 512) hist[i] = 0u;
    __syncthreads();
    for (int i = tid; i < n; i += 512) { const unsigned k = keys[pidx(i)]; if ((k >> 21) == binA) __hip_atomic_fetch_add(&hist[(k >> 10) & 2047u], 1u, __ATOMIC_RELAXED, __HIP_MEMORY_SCOPE_WORKGROUP); }
    __syncthreads();
    if (wave == 0) select_bin(hist, 2048, want, res, lane);
    __syncthreads();
    const unsigned binB = res[0]; want -= res[1];
    __syncthreads();
    for (int i = tid; i < 2048; i += 512) hist[i] = 0u;
    __syncthreads();
    const unsigned hiAB = (binA << 11) | binB;
    for (int i = tid; i < n; i += 512) { const unsigned k = keys[pidx(i)]; if ((k >> 10) == hiAB) __hip_atomic_fetch_add(&hist[k & 1023u], 1u, __ATOMIC_RELAXED, __HIP_MEMORY_SCOPE_WORKGROUP); }
    __syncthreads();
    if (wave == 0) select_bin(hist, 1024, want, res, lane);
    __syncthreads();
    const unsigned binC = res[0]; const unsigned rtie = want - res[1];
    const unsigned T = (hiAB << 10) | binC;
    const int L = n >> 9;
    unsigned cg = 0, ce = 0;
    for (int k = 0; k < L; ++k) { const unsigned key = keys[pidx((unsigned)(tid * L + k))]; cg += key > T ? 1u : 0u; ce += key == T ? 1u : 0u; }
    unsigned ig = cg, ie = ce;
#pragma unroll
    for (int o = 1; o < 64; o <<= 1) { const unsigned ug = __shfl_up(ig, o), ue = __shfl_up(ie, o); if (lane >= o) { ig += ug; ie += ue; } }
    if (lane == 63) { res[16 + wave] = ig; res[32 + wave] = ie; }
    __syncthreads();
    unsigned pg = ig - cg, pe = ie - ce;
    for (int w = 0; w < wave; ++w) { pg += res[16 + w]; pe += res[32 + w]; }
    int* idx = (int*)(C.ws + WS_IDX); int* smapT = (int*)(C.ws + WS_SMAP) + (size_t)e * NT + tok0;
    for (int k = 0; k < L; ++k) {
        const unsigned pi = pidx((unsigned)(tid * L + k));
        const unsigned key = keys[pi];
        const bool isg = key > T, ise = key == T, sel = isg || (ise && pe < rtie);
        const unsigned slot = pg + (pe < rtie ? pe : rtie);
        keys[pi] = sel ? (unsigned)(slot0 + slot) : 0xffffffffu;
        if (sel) idx[slot0 + slot] = tok0 + tid * L + k;
        pg += isg ? 1u : 0u; pe += ise ? 1u : 0u;
    }
    __syncthreads();
    for (int i = tid; i < n; i += 512) smapT[i] = (int)keys[pidx(i)];
    __syncthreads();
}
__device__ __forceinline__ void transpose64_item(const float* W, int ldw, int k0, int n0, bf16* dst, int ldd, LAS unsigned char* scr, int lane) {
    const int kq = lane >> 4, nq = lane & 15;
    f32x4 v[16];
    const float* src = W + (size_t)(k0 + 16 * kq) * ldw + n0 + 4 * nq;
#pragma unroll
    for (int i = 0; i < 16; ++i) v[i] = __builtin_nontemporal_load((const f32x4*)(src + (size_t)i * ldw));
#pragma unroll
    for (int j = 0; j < 4; ++j) {
        v4u lo, hi;
        lo.x = pk2(v[0][j], v[1][j]); lo.y = pk2(v[2][j], v[3][j]); lo.z = pk2(v[4][j], v[5][j]); lo.w = pk2(v[6][j], v[7][j]);
        hi.x = pk2(v[8][j], v[9][j]); hi.y = pk2(v[10][j], v[11][j]); hi.z = pk2(v[12][j], v[13][j]); hi.w = pk2(v[14][j], v[15][j]);
        LAS unsigned char* p = scr + (4 * nq + j) * 144 + kq * 32;
        *(LAS v4u*)p = lo; *(LAS v4u*)(p + 16) = hi;
    }
    LDS_WAIT(); asm volatile("" ::: "memory");
    const int c = lane & 7;
#pragma unroll
    for (int jj = 0; jj < 8; ++jj) { const int n = (lane >> 3) + 8 * jj; const v4u o = *(const LAS v4u*)(scr + n * 144 + c * 16); *(v4u*)(dst + (size_t)n * ldd + k0 + 8 * c) = o; }
    LDS_WAIT(); asm volatile("" ::: "memory");
}
__device__ __forceinline__ void transpose_fp8_item(const float* W, int ldw, int k0, int n0, unsigned char* dst, int ldd, LAS unsigned char* scr, int lane, float scale) {
    const int kq = lane >> 3, nq = lane & 7;
    f32x4 v[16];
    const float* src = W + (size_t)(k0 + 16 * kq) * ldw + n0 + 4 * nq;
#pragma unroll
    for (int i = 0; i < 16; ++i) v[i] = __builtin_nontemporal_load((const f32x4*)(src + (size_t)i * ldw));
#pragma unroll
    for (int j = 0; j < 4; ++j) {
        int w[4];
#pragma unroll
        for (int g = 0; g < 4; ++g) { int t = 0; t = __builtin_amdgcn_cvt_pk_fp8_f32(fp8c(v[4 * g][j] * scale), fp8c(v[4 * g + 1][j] * scale), t, false); t = __builtin_amdgcn_cvt_pk_fp8_f32(fp8c(v[4 * g + 2][j] * scale), fp8c(v[4 * g + 3][j] * scale), t, true); w[g] = t; }
        v4u o; o.x = (unsigned)w[0]; o.y = (unsigned)w[1]; o.z = (unsigned)w[2]; o.w = (unsigned)w[3];
        *(LAS v4u*)(scr + (4 * nq + j) * 144 + kq * 16) = o;
    }
    LDS_WAIT(); asm volatile("" ::: "memory");
    const int c = lane & 7;
#pragma unroll
    for (int jj = 0; jj < 4; ++jj) { const int n = (lane >> 3) + 8 * jj; const v4u o = *(const LAS v4u*)(scr + n * 144 + c * 16); *(v4u*)(dst + (size_t)n * ldd + k0 + 16 * c) = o; }
    LDS_WAIT(); asm volatile("" ::: "memory");
}
struct CvItem { const float* src; unsigned char* dst; int ldw, ldd; float scale; };
__device__ __forceinline__ CvItem cv_desc(const Ctx& C, int layer, unsigned char* BT1, unsigned char* BT2, int it) {
    const int e = it / 1536, rem = it % 1536, mat = rem >> 9, r2 = rem & 511;
    const size_t woff = (size_t)(layer * NE + e) * D * FF; CvItem d;
    if (mat < 2) {
        const int kb = r2 >> 6, n0 = (r2 & 63) * 32, row = 256 * (n0 >> 7) + (mat ? 128 : 0) + (n0 & 127);
        d.src = (mat ? C.in_up : C.in_gate) + woff + (size_t)(kb * 128) * FF + n0; d.ldw = FF; d.scale = mat ? 32.0f : -32.0f * 1.4426950408889634f;
        d.dst = BT1 + (size_t)e * 4096 * D + (size_t)row * D + kb * 128; d.ldd = D;
    } else {
        const int kb = r2 >> 5, n0 = (r2 & 31) * 32;
        d.src = C.in_down + woff + (size_t)(kb * 128) * D + n0; d.ldw = D; d.scale = 32.0f; d.dst = BT2 + (size_t)e * D * FF + (size_t)n0 * FF + kb * 128; d.ldd = FF;
    }
    return d;
}
__device__ __forceinline__ void cv_load(const CvItem& d, f32x4 (&v)[16], int lane) {
    const float* src = d.src + (size_t)(16 * (lane >> 3)) * d.ldw + 4 * (lane & 7);
#pragma unroll
    for (int i = 0; i < 16; ++i) v[i] = __builtin_nontemporal_load((const f32x4*)(src + (size_t)i * d.ldw));
}
__device__ __forceinline__ void cv_finish(const CvItem& d, const f32x4 (&v)[16], LAS unsigned char* scr, int lane) {
    const int kq = lane >> 3, nq = lane & 7;
#pragma unroll
    for (int j = 0; j < 4; ++j) {
        int w[4];
#pragma unroll
        for (int g = 0; g < 4; ++g) { int t = 0; t = __builtin_amdgcn_cvt_pk_fp8_f32(fp8c(v[4 * g][j] * d.scale), fp8c(v[4 * g + 1][j] * d.scale), t, false); t = __builtin_amdgcn_cvt_pk_fp8_f32(fp8c(v[4 * g + 2][j] * d.scale), fp8c(v[4 * g + 3][j] * d.scale), t, true); w[g] = t; }
        v4u o; o.x = (unsigned)w[0]; o.y = (unsigned)w[1]; o.z = (unsigned)w[2]; o.w = (unsigned)w[3];
        *(LAS v4u*)(scr + (4 * nq + j) * 144 + kq * 16) = o;
    }
    LDS_WAIT(); asm volatile("" ::: "memory");
    const int c = lane & 7;
#pragma unroll
    for (int jj = 0; jj < 4; ++jj) { const int n = (lane >> 3) + 8 * jj; const v4u o = *(const LAS v4u*)(scr + n * 144 + c * 16); *(v4u*)(d.dst + (size_t)n * d.ldd + 16 * c) = o; }
    LDS_WAIT(); asm volatile("" ::: "memory");
}
__device__ __forceinline__ void moe_convert_range(const Ctx& C, int layer, unsigned char* BT1, unsigned char* BT2, int gw, int NGW, int lo, int hi) {
    LAS unsigned char* scr = C.lds + C.wave * 16384;
    int it = lo + gw; if (it >= hi) return;
    f32x4 va[16], vb[16]; CvItem da = cv_desc(C, layer, BT1, BT2, it), db = da;
    cv_load(da, va, C.lane);
    for (;;) {
        const int itb = it + NGW; const bool hb = itb < hi;
        if (hb) { db = cv_desc(C, layer, BT1, BT2, itb); cv_load(db, vb, C.lane); }
        cv_finish(da, va, scr, C.lane);
        if (!hb) break;
        it = itb + NGW; const bool ha = it < hi;
        if (ha) { da = cv_desc(C, layer, BT1, BT2, it); cv_load(da, va, C.lane); }
        cv_finish(db, vb, scr, C.lane);
        if (!ha) break;
    }
}
constexpr int CV_ITEMS = NE * 1536;
__device__ __forceinline__ void combine_phase(const Ctx& C, int layer, bool do_norm) {
    const float* modl = (const float*)(C.ws + WS_MOD) + (size_t)layer * NB * 6144;
    const float* modn = (const float*)(C.ws + WS_MOD) + (size_t)(layer + 1) * NB * 6144;
    const float* gain = C.in_norm1 + (layer + 1) * D;
    const unsigned char* Y = C.ws + WS_Y; bf16* H = (bf16*)(C.ws + WS_H);
    const float* aff = (const float*)(C.ws + WS_AFF); const int* smap = (const int*)(C.ws + WS_SMAP);
    const int lane = C.lane;
    RowMod M; M.bcur = -1; f32x4 g2v[4]; int bg = -1;
    LAS float* wn = (LAS float*)C.lds;
    if (do_norm) { float wv[8];
#pragma unroll
        for (int u = 0; u < 8; ++u) wv[u] = ((const float*)(C.ws + WS_WN))[C.tid + 512 * u];
#pragma unroll
        for (int u = 0; u < 8; ++u) wn[C.tid + 512 * u] = wv[u];
        __syncthreads(); }
    for (int i = 0; i < TOK_PER_WAVE / TB; ++i) {
        const int tokb = C.blk * TOK_PER_BLK + C.wave * TOK_PER_WAVE + TB * i, b = tokb >> 11;
        if (b != bg) {
#pragma unroll
            for (int j = 0; j < 4; ++j) g2v[j] = *(const f32x4*)(modl + (size_t)b * 6144 + 5 * 1024 + COLJ(j, lane));
            bg = b; }
        const int sm = smap[(size_t)(lane & 15) * NT + tokb + (lane >> 4)]; const float af = aff[(size_t)tokb * NE + (lane >> 4) * NE + (lane & 15)];
        bf16* xr = (bf16*)(C.ws + WS_XB) + (size_t)tokb * D; float* outr = C.out + (size_t)tokb * D;
        f32x4 v[TB][4];
#pragma unroll
        for (int q = 0; q < TB; ++q) load_row_bf16(xr + q * D, v[q], lane);
        const unsigned long long maskall = __ballot(sm >= 0);
#pragma unroll
        for (int q = 0; q < TB; ++q) {
            f32x4 acc[4];
#pragma unroll
            for (int j = 0; j < 4; ++j) acc[j] = (f32x4){0.f, 0.f, 0.f, 0.f};
            unsigned mask = (unsigned)(maskall >> (16 * q)) & 0xffffu;
            while (mask) {
                const int e0 = __builtin_ctz(mask); mask &= mask - 1u;
                const bool two = mask != 0u; const int e1 = two ? __builtin_ctz(mask) : e0; if (two) mask &= mask - 1u;
                const int s0 = __shfl(sm, 16 * q + e0), s1 = __shfl(sm, 16 * q + e1);
                const float a0 = __shfl(af, 16 * q + e0), a1 = two ? __shfl(af, 16 * q + e1) : 0.f;
                const unsigned char* y0 = Y + (size_t)s0 * D + 8 * lane; const unsigned char* y1 = Y + (size_t)s1 * D + 8 * lane;
                v2u w0[2], w1[2];
#pragma unroll
                for (int jp = 0; jp < 2; ++jp) { w0[jp] = *(const v2u*)(y0 + 512 * jp); w1[jp] = *(const v2u*)(y1 + 512 * jp); }
#pragma unroll
                for (int jp = 0; jp < 2; ++jp) {
                    typedef float f32x2_ __attribute__((ext_vector_type(2)));
                    const f32x2_ p0 = __builtin_amdgcn_cvt_pk_f32_fp8((int)w0[jp].x, false), p1 = __builtin_amdgcn_cvt_pk_f32_fp8((int)w0[jp].x, true), p2 = __builtin_amdgcn_cvt_pk_f32_fp8((int)w0[jp].y, false), p3 = __builtin_amdgcn_cvt_pk_f32_fp8((int)w0[jp].y, true);
                    const f32x2_ r0 = __builtin_amdgcn_cvt_pk_f32_fp8((int)w1[jp].x, false), r1 = __builtin_amdgcn_cvt_pk_f32_fp8((int)w1[jp].x, true), r2 = __builtin_amdgcn_cvt_pk_f32_fp8((int)w1[jp].y, false), r3 = __builtin_amdgcn_cvt_pk_f32_fp8((int)w1[jp].y, true);
                    acc[2 * jp].x += a0 * p0.x; acc[2 * jp].y += a0 * p0.y; acc[2 * jp].z += a0 * p1.x; acc[2 * jp].w += a0 * p1.y;
                    acc[2 * jp + 1].x += a0 * p2.x; acc[2 * jp + 1].y += a0 * p2.y; acc[2 * jp + 1].z += a0 * p3.x; acc[2 * jp + 1].w += a0 * p3.y;
                    acc[2 * jp].x += a1 * r0.x; acc[2 * jp].y += a1 * r0.y; acc[2 * jp].z += a1 * r1.x; acc[2 * jp].w += a1 * r1.y;
                    acc[2 * jp + 1].x += a1 * r2.x; acc[2 * jp + 1].y += a1 * r2.y; acc[2 * jp + 1].z += a1 * r3.x; acc[2 * jp + 1].w += a1 * r3.y; }
            }
#pragma unroll
            for (int j = 0; j < 4; ++j) v[q][j] = v[q][j] + g2v[j] * acc[j];
            if (do_norm) store_row_bf16(xr + q * D, v[q], lane);
            else {
#pragma unroll
                for (int j = 0; j < 4; ++j) *(f32x4*)(outr + q * D + COLJ(j, lane)) = v[q][j];
            }
        }
        if (do_norm) {
            if (b != M.bcur) load_rowmod(M, modn, gain, b, 0, lane);
            float rinv[TB];
            sumsq4(v, rinv);
#pragma unroll
            for (int q = 0; q < TB; ++q) {
#pragma unroll
                for (int j = 0; j < 4; ++j) v[q][j] = v[q][j] * rinv[q] * M.a[j] + M.b[j];
                store_row_bf16(H + (size_t)(tokb + q) * D, v[q], lane);
            }
            float p[16];
#pragma unroll
            for (int g = 0; g < 4; ++g) {
                f32x4 w[4];
#pragma unroll
                for (int j = 0; j < 4; ++j) w[j] = *(const LAS f32x4*)(wn + g * D + COLJ(j, lane));
#pragma unroll
                for (int q = 0; q < TB; ++q) { f32x4 P = v[q][0] * w[0];
#pragma unroll
                    for (int j = 1; j < 4; ++j) P = v[q][j] * w[j] + P;
                    p[q * 4 + g] = (P.x + P.y) + (P.z + P.w); }
                asm volatile("" : "+v"(p[g]), "+v"(p[4 + g]), "+v"(p[8 + g]), "+v"(p[12 + g]) :: "memory");
            }
            float q8[8], q4[4], q2[2], q1;
            { const bool hi = (lane & 32) != 0;
#pragma unroll
              for (int k = 0; k < 8; ++k) { const float keep = hi ? p[k + 8] : p[k], send = hi ? p[k] : p[k + 8]; q8[k] = keep + __shfl_xor(send, 32); } }
            { const bool hi = (lane & 16) != 0;
#pragma unroll
              for (int k = 0; k < 4; ++k) { const float keep = hi ? q8[k + 4] : q8[k], send = hi ? q8[k] : q8[k + 4]; q4[k] = keep + __shfl_xor(send, 16); } }
            { const bool hi = (lane & 8) != 0;
#pragma unroll
              for (int k = 0; k < 2; ++k) { const float keep = hi ? q4[k + 2] : q4[k], send = hi ? q4[k] : q4[k + 2]; q2[k] = keep + __shfl_xor(send, 8); } }
            { const bool hi = (lane & 4) != 0; const float keep = hi ? q2[1] : q2[0], send = hi ? q2[0] : q2[1]; q1 = keep + __shfl_xor(send, 4); }
            q1 += __shfl_xor(q1, 2); q1 += __shfl_xor(q1, 1);
            if ((lane & 3) == 0) ((float*)(C.ws + WS_V128))[(size_t)tokb * 4 + (lane >> 2)] = q1;
        }
    }
}

__device__ __forceinline__ void f128_task(const Ctx& C) {
    LAS float* ct = (LAS float*)C.lds;
    LAS f32x4* vb = (LAS f32x4*)(C.lds + 8192);
    for (int i = C.tid; i < 2048; i += 512) { float s, c; sincospif((float)i * (1.0f / 1024.0f), &s, &c); ct[i] = c; }
    const f32x4* V = (const f32x4*)(C.ws + WS_V128); float* F = (float*)(C.ws + WS_F128);
    const int lane = C.lane;
    const int it0 = C.blk * (NT / 256), it1 = it0 + NT / 256;
    for (int bb = it0 >> 11; bb <= (it1 - 1) >> 11; ++bb) {
        __syncthreads();
        { f32x4 t4[4];
#pragma unroll
          for (int u = 0; u < 4; ++u) t4[u] = V[(size_t)bb * TSEQ + C.tid + 512 * u];
#pragma unroll
          for (int u = 0; u < 4; ++u) vb[C.tid + 512 * u] = t4[u]; }
        __syncthreads();
        const int lo = it0 > (bb << 11) ? it0 : (bb << 11), hi = it1 < ((bb + 1) << 11) ? it1 : ((bb + 1) << 11);
        for (int it = lo + C.wave; it < hi; it += NWAVES) {
            const int k1 = it & 2047;
            f32x4 acc = (f32x4){0.f, 0.f, 0.f, 0.f};
#pragma unroll 8
            for (int i = 0; i < 32; ++i) { const int t = lane + 64 * i; const float c = ct[(k1 * t) & 2047]; acc = acc + vb[t] * c; }
            float r2[2], r1;
            { const bool hi5 = (lane & 32) != 0; const float k0 = hi5 ? acc.z : acc.x, s0 = hi5 ? acc.x : acc.z, k1v = hi5 ? acc.w : acc.y, s1 = hi5 ? acc.y : acc.w; r2[0] = k0 + __shfl_xor(s0, 32); r2[1] = k1v + __shfl_xor(s1, 32); }
            { const bool hi4 = (lane & 16) != 0; const float keep = hi4 ? r2[1] : r2[0], send = hi4 ? r2[0] : r2[1]; r1 = keep + __shfl_xor(send, 16); }
            r1 += __shfl_xor(r1, 8); r1 += __shfl_xor(r1, 4); r1 += __shfl_xor(r1, 2); r1 += __shfl_xor(r1, 1);
            if ((lane & 15) == 0) F[(size_t)it * 4 + (lane >> 4)] = r1 * 0.022097086912079608f;
        }
    }
}

template <int MODE> struct Sched : pg8::OrderBase {
    const char* A0; const char* B0; size_t sA, sB, sE;
    __device__ __forceinline__ bool next(int i, pg8::Unit& u) const {
        if (!idx(i, u.pm, u.pn)) return false;
        if (MODE == 0) { u.A = A0 + (size_t)u.pm * sA; u.B = B0 + (size_t)u.pn * sB; }
        if (MODE == 1) { const int e = u.pm < 256 ? (u.pm >> 4) : ((u.pm - 256) >> 3); u.A = A0 + (size_t)u.pm * sA; u.B = B0 + (size_t)e * sE + (size_t)u.pn * sB; }
        if (MODE == 2) { u.A = A0 + (size_t)(u.pm & 7) * sA; u.B = B0 + (size_t)(u.pm >> 3) * sE + (size_t)u.pn * sB; }
        if (MODE == 3) { const int q = u.pm & 3;
            u.A = A0 + (size_t)((u.pn >> 1) * 2 + (q >> 1)) * (sA * 2) + (size_t)(q & 1) * sA; u.B = B0 + (size_t)(((u.pm >> 2) * 2 + (u.pn >> 1)) * 2 + (q >> 1)) * sE + (size_t)(u.pn & 1) * sB; }
        if (MODE == 4) { u.A = A0 + (size_t)u.pm * sA; u.B = B0 + (size_t)((u.pn >> 3) * 2048 + (u.pn & 7) * 128) * sB; }
        return true;
    }
};
typedef pg8::f32x4 (&AccRef)[2][2][4][2];

struct EpiQK {
    static constexpr bool PERM = true; static constexpr int NVM = 16;
    bf16* Q; bf16* Kb; const float* qg; const float* kg;
    __device__ __forceinline__ void operator()(const pg8::f32x4 (&acc)[2][2][4][2], const pg8::Unit& u, int wr, int wc, int fr, int fq) const {
        const int sec = u.pn >> 2, head = 4 * (u.pn & 3) + wc;
        bf16* out = (sec ? Kb : Q) + head * HD + 8 * fq;
        const float* gp = (sec ? kg : qg) + 8 * fq; const float scl = sec ? 1.0f : 0.125f * 1.4426950408889634f;
        f32x4 g[2][2];
#pragma unroll
        for (int bj = 0; bj < 2; ++bj)
#pragma unroll
            for (int n = 0; n < 2; ++n) g[bj][n] = *(const f32x4*)(gp + 32 * bj + 4 * n) * (scl * 0.03125f);
        const int row0 = u.pm * 256 + wr * 64 + fr;
#pragma unroll
        for (int ai = 0; ai < 2; ++ai)
#pragma unroll
            for (int m = 0; m < 4; ++m) {
                float ss = 0.f;
#pragma unroll
                for (int bj = 0; bj < 2; ++bj)
#pragma unroll
                    for (int n = 0; n < 2; ++n) { const f32x4 x = acc[ai][bj][m][n]; ss += (x.x * x.x + x.y * x.y) + (x.z * x.z + x.w * x.w); }
                ss += __shfl_xor(ss, 16); ss += __shfl_xor(ss, 32);
                const float rinv = 1.0f / sqrtf(ss * (1.0f / (HD * 1024.0f)) + EPS);
                bf16* rowp = out + (size_t)(row0 + ai * 128 + m * 16) * D;
#pragma unroll
                for (int bj = 0; bj < 2; ++bj) { const f32x4 v0 = acc[ai][bj][m][0] * rinv * g[bj][0], v1 = acc[ai][bj][m][1] * rinv * g[bj][1];
                    v4u w; w.x = pg8::cvt_pk_bf16(v0.x, v0.y); w.y = pg8::cvt_pk_bf16(v0.z, v0.w); w.z = pg8::cvt_pk_bf16(v1.x, v1.y); w.w = pg8::cvt_pk_bf16(v1.z, v1.w);
                    *(v4u*)(rowp + 32 * bj) = w; }
            }
    }
};
template <int MODE> struct EpiStore {
    static constexpr bool PERM = true; static constexpr int NVM = 16;
    bf16* O; size_t ldc; float scale;
    __device__ __forceinline__ void operator()(const pg8::f32x4 (&acc)[2][2][4][2], const pg8::Unit& u, int wr, int wc, int fr, int fq) const {
        bf16* base; size_t ld;
        if (MODE == 0) { base = O + (size_t)u.pm * 256 * ldc + (size_t)u.pn * 256; ld = ldc; }
        else { const int part = u.pm >> 1, col0 = (u.pm & 1) * 256, b = u.pn >> 3, t0 = (u.pn & 7) * 256; base = O + (((size_t)(b * 2 + part) * 512 + col0) * 2048 + t0); ld = 2048; }
        base += (size_t)(wr * 64 + fr) * ld + wc * 32 + 8 * fq;
#pragma unroll
        for (int ai = 0; ai < 2; ++ai)
#pragma unroll
            for (int m = 0; m < 4; ++m) { bf16* rowp = base + (size_t)(ai * 128 + m * 16) * ld;
#pragma unroll
                for (int bj = 0; bj < 2; ++bj) { const f32x4 v0 = acc[ai][bj][m][0] * scale, v1 = acc[ai][bj][m][1] * scale;
                    v4u w; w.x = pg8::cvt_pk_bf16(v0.x, v0.y); w.y = pg8::cvt_pk_bf16(v0.z, v0.w); w.z = pg8::cvt_pk_bf16(v1.x, v1.y); w.w = pg8::cvt_pk_bf16(v1.z, v1.w);
                    *(v4u*)(rowp + bj * 128) = w; } }
    }
};
struct EpiEO {
    static constexpr bool PERM = true; static constexpr int NVM = 16;
    bf16* O;
    __device__ __forceinline__ void operator()(const pg8::f32x4 (&acc)[2][2][4][2], const pg8::Unit& u, int wr, int wc, int fr, int fq) const {
        const int part = u.pm >> 1, ch0 = (u.pm & 1) * 256 + wr * 64 + fr, b = u.pn >> 3, t0 = (u.pn & 7) * 128 + wc * 32 + 8 * fq;
        bf16* be = O + ((((size_t)(b * 2 + part) * 2) * 512 + ch0) * 1024 + t0); bf16* bo = be + (size_t)512 * 1024;
#pragma unroll
        for (int ai = 0; ai < 2; ++ai)
#pragma unroll
            for (int m = 0; m < 4; ++m) { const size_t ro = (size_t)(ai * 128 + m * 16) * 1024;
                const f32x4 e0 = acc[ai][0][m][0] + acc[ai][1][m][0], e1 = acc[ai][0][m][1] + acc[ai][1][m][1], o0 = acc[ai][0][m][0] - acc[ai][1][m][0], o1 = acc[ai][0][m][1] - acc[ai][1][m][1];
                v4u w; w.x = pg8::cvt_pk_bf16(e0.x, e0.y); w.y = pg8::cvt_pk_bf16(e0.z, e0.w); w.z = pg8::cvt_pk_bf16(e1.x, e1.y); w.w = pg8::cvt_pk_bf16(e1.z, e1.w);
                *(v4u*)(be + ro) = w;
                v4u x; x.x = pg8::cvt_pk_bf16(o0.x, o0.y); x.y = pg8::cvt_pk_bf16(o0.z, o0.w); x.z = pg8::cvt_pk_bf16(o1.x, o1.y); x.w = pg8::cvt_pk_bf16(o1.z, o1.w);
                *(v4u*)(bo + ro) = x; }
    }
};
struct EpiY8 {
    static constexpr bool PERM = true; static constexpr int NVM = 16;
    unsigned char* Y;
    __device__ __forceinline__ void operator()(const pg8::f32x4 (&acc)[2][2][4][2], const pg8::Unit& u, int wr, int wc, int fr, int fq) const {
        unsigned char* base = Y + (size_t)(u.pm * 256 + wr * 64 + fr) * D + (size_t)u.pn * 256 + wc * 32 + 8 * fq;
#pragma unroll
        for (int ai = 0; ai < 2; ++ai)
#pragma unroll
            for (int m = 0; m < 4; ++m)
#pragma unroll
                for (int bj = 0; bj < 2; ++bj) { const f32x4 v0 = acc[ai][bj][m][0], v1 = acc[ai][bj][m][1]; int w0 = 0, w1 = 0;
                    w0 = __builtin_amdgcn_cvt_pk_fp8_f32(fp8c(v0.x), fp8c(v0.y), w0, false); w0 = __builtin_amdgcn_cvt_pk_fp8_f32(fp8c(v0.z), fp8c(v0.w), w0, true);
                    w1 = __builtin_amdgcn_cvt_pk_fp8_f32(fp8c(v1.x), fp8c(v1.y), w1, false); w1 = __builtin_amdgcn_cvt_pk_fp8_f32(fp8c(v1.z), fp8c(v1.w), w1, true);
                    v2u w; w.x = (unsigned)w0; w.y = (unsigned)w1; *(v2u*)(base + (size_t)(ai * 128 + m * 16) * D + bj * 128) = w; }
    }
};
struct EpiVT {
    static constexpr bool PERM = true; static constexpr int NVM = 16;
    bf16* VT;
    __device__ __forceinline__ void operator()(const pg8::f32x4 (&acc)[2][2][4][2], const pg8::Unit& u, int wr, int wc, int fr, int fq) const {
#pragma unroll
        for (int ai = 0; ai < 2; ++ai)
#pragma unroll
            for (int m = 0; m < 4; ++m) { const int rho = u.pm * 256 + ai * 128 + wr * 64 + m * 16 + fr, h = rho >> 6, d = rho & 63;
#pragma unroll
                for (int bj = 0; bj < 2; ++bj) { const int tau = u.pn * 256 + bj * 128 + wc * 32 + 8 * fq, b = tau >> 11, r = (tau >> 6) & 31, cg = (tau >> 3) & 7;
                    const f32x4 v0 = acc[ai][bj][m][0] * 0.03125f, v1 = acc[ai][bj][m][1] * 0.03125f;
                    v4u w; w.x = pg8::cvt_pk_bf16(v0.x, v0.y); w.y = pg8::cvt_pk_bf16(v0.z, v0.w); w.z = pg8::cvt_pk_bf16(v1.x, v1.y); w.w = pg8::cvt_pk_bf16(v1.z, v1.w);
                    *(v4u*)(VT + ((size_t)(((b * NHEAD + h) * 32 + r) * 8 + cg) * 64 + d) * 8) = w; } }
    }
};
struct EpiPQ {
    static constexpr bool PERM = true; static constexpr int NVM = 32;
    bf16* O; const float* F128;
    __device__ __forceinline__ void operator()(const pg8::f32x4 (&acc)[2][2][4][2], const pg8::Unit& u, int wr, int wc, int fr, int fq) const {
        const int b = u.pm >> 2, q = u.pm & 3, par = q >> 1, r0 = (q & 1) * 256 + wr * 64 + fr;
        bf16* base = O + (size_t)b * TSEQ * D + (size_t)u.pn * 256 + wc * 32 + 8 * fq;
        const bool inj = (u.pn >= 2) && (wc == 0) && (fq == 0);
        const float qs = u.pn >= 2 ? -1.0f : 1.0f;
#pragma unroll
        for (int ai = 0; ai < 2; ++ai)
#pragma unroll
            for (int m = 0; m < 4; ++m) { const int k = 2 * (r0 + ai * 128 + m * 16) + par, km = (TSEQ - k) & (TSEQ - 1);
                bf16* rowp = base + (size_t)k * D; bf16* rowm = base + (size_t)km * D;
                f32x4 fz = (f32x4){0.f, 0.f, 0.f, 0.f}, fm = fz;
                if (inj) { fz = *(const f32x4*)(F128 + ((size_t)b * TSEQ + k) * 4); fm = *(const f32x4*)(F128 + ((size_t)b * TSEQ + km) * 4); }
#pragma unroll
                for (int bj = 0; bj < 2; ++bj) { f32x4 v0 = acc[ai][bj][m][0]; const f32x4 v1 = acc[ai][bj][m][1]; f32x4 m0 = v0 * qs; const f32x4 m1 = v1 * qs;
                    if (inj) { const int g = 2 * (u.pn - 2) + bj; v0.x = g == 0 ? fz.x : (g == 1 ? fz.y : (g == 2 ? fz.z : fz.w)); m0.x = g == 0 ? fm.x : (g == 1 ? fm.y : (g == 2 ? fm.z : fm.w)); }
                    v4u w; w.x = pg8::cvt_pk_bf16(v0.x, v0.y); w.y = pg8::cvt_pk_bf16(v0.z, v0.w); w.z = pg8::cvt_pk_bf16(v1.x, v1.y); w.w = pg8::cvt_pk_bf16(v1.z, v1.w);
                    *(v4u*)(rowp + bj * 128) = w;
                    if (k != 0) { v4u x; x.x = pg8::cvt_pk_bf16(m0.x, m0.y); x.y = pg8::cvt_pk_bf16(m0.z, m0.w); x.z = pg8::cvt_pk_bf16(m1.x, m1.y); x.w = pg8::cvt_pk_bf16(m1.z, m1.w);
                        *(v4u*)(rowm + bj * 128) = x; } } }
    }
};
__device__ __forceinline__ void pq_nyq_task(const Ctx& C) {
    const bf16* VT2 = (const bf16*)(C.ws + WS_VT2); bf16* H = (bf16*)(C.ws + WS_H); const float* F128 = (const float*)(C.ws + WS_F128);
    const int lane = C.lane;
    if (C.blk < 128) return;
    for (int row = (C.blk - 128) * NWAVES + C.wave; row < NB * 512; row += 128 * NWAVES) {
        const int b = row >> 9, c = row & 511;
        const bf16* src = VT2 + ((size_t)(b * 2) * 2 * 512 + c) * 1024 + lane * 16;
        float s = 0.f;
#pragma unroll
        for (int j = 0; j < 2; ++j) { const v4u w = *(const v4u*)(src + 8 * j);
            s += (bf_lo(w.x) - bf_hi(w.x)) + (bf_lo(w.y) - bf_hi(w.y)) + (bf_lo(w.z) - bf_hi(w.z)) + (bf_lo(w.w) - bf_hi(w.w)); }
#pragma unroll
        for (int o = 1; o < 64; o <<= 1) s += __shfl_xor(s, o);
        if (lane == 0) H[((size_t)b * TSEQ + 1024) * D + c] = (bf16)f2bf(s * 0.022097086912079608f);
    }
    if (C.blk < 128 + NB && C.wave == 0) {
        const size_t tok = (size_t)(C.blk - 128) * TSEQ + 1024;
        const float f = (lane & 15) == 0 ? F128[tok * 4 + (lane >> 4)] : 0.f;
        v4u w; w.x = pk2(f, 0.f); w.y = 0u; w.z = 0u; w.w = 0u;
        *(v4u*)(H + tok * D + 512 + lane * 8) = w;
    }
}
struct EpiRes {
    static constexpr bool PERM = true; static constexpr int NVM = 16;
    const float* xp; const float* xs; bf16* XB; const float* modg; int src_is_xb;
    __device__ __forceinline__ void operator()(const pg8::f32x4 (&acc)[2][2][4][2], const pg8::Unit& u, int wr, int wc, int fr, int fq) const {
        const int row0 = u.pm * 256 + wr * 64 + fr, col0 = u.pn * 256 + wc * 32 + 8 * fq, b = u.pm >> 3;
        const float* gb = modg + (size_t)b * 6144 + col0;
        f32x4 gv[2][2];
#pragma unroll
        for (int bj = 0; bj < 2; ++bj)
#pragma unroll
            for (int n = 0; n < 2; ++n) gv[bj][n] = *(const f32x4*)(gb + bj * 128 + 4 * n);
        const float* X = u.pm < 128 ? xp : xs - (size_t)NP * D;
#pragma unroll
        for (int ai = 0; ai < 2; ++ai)
#pragma unroll
            for (int m = 0; m < 4; ++m) { const size_t off = (size_t)(row0 + ai * 128 + m * 16) * D + col0;
#pragma unroll
                for (int bj = 0; bj < 2; ++bj) {
                    f32x4 x0, x1;
                    if (src_is_xb) { const v4u w = *(const v4u*)(XB + off + bj * 128); x0 = (f32x4){bf_lo(w.x), bf_hi(w.x), bf_lo(w.y), bf_hi(w.y)}; x1 = (f32x4){bf_lo(w.z), bf_hi(w.z), bf_lo(w.w), bf_hi(w.w)}; }
                    else { x0 = *(const f32x4*)(X + off + bj * 128); x1 = *(const f32x4*)(X + off + bj * 128 + 4); }
                    const f32x4 v0 = x0 + gv[bj][0] * acc[ai][bj][m][0], v1 = x1 + gv[bj][1] * acc[ai][bj][m][1];
                    v4u o; o.x = pg8::cvt_pk_bf16(v0.x, v0.y); o.y = pg8::cvt_pk_bf16(v0.z, v0.w); o.z = pg8::cvt_pk_bf16(v1.x, v1.y); o.w = pg8::cvt_pk_bf16(v1.z, v1.w);
                    *(v4u*)(XB + off + bj * 128) = o; } }
    }
};
struct EpiAct {
    static constexpr bool PERM = true; static constexpr int NVM = 8;
    unsigned char* ACT;
    __device__ __forceinline__ void operator()(const pg8::f32x4 (&acc)[2][2][4][2], const pg8::Unit& u, int wr, int wc, int fr, int fq) const {
        unsigned char* base = ACT + (size_t)u.pm * 256 * FF + (size_t)u.pn * 128 + wc * 32 + 8 * fq + (size_t)(wr * 64 + fr) * FF;
#pragma unroll
        for (int ai = 0; ai < 2; ++ai)
#pragma unroll
            for (int m = 0; m < 4; ++m) {
                float hv[8];
#pragma unroll
                for (int n = 0; n < 2; ++n) { const f32x4 A = acc[ai][0][m][n], U = acc[ai][1][m][n]; f32x4 T = A;
#pragma unroll
                    for (int j = 0; j < 4; ++j) T[j] = __builtin_amdgcn_exp2f(T[j]);
                    T = T + 1.0f;
#pragma unroll
                    for (int j = 0; j < 4; ++j) T[j] = __builtin_amdgcn_rcpf(T[j]);
                    const f32x4 Hh = (A * U) * (T * -0.6931471805599453f);
#pragma unroll
                    for (int j = 0; j < 4; ++j) hv[4 * n + j] = Hh[j]; }
                int w0 = 0, w1 = 0;
                w0 = __builtin_amdgcn_cvt_pk_fp8_f32(fp8c(hv[0]), fp8c(hv[1]), w0, false); w0 = __builtin_amdgcn_cvt_pk_fp8_f32(fp8c(hv[2]), fp8c(hv[3]), w0, true);
                w1 = __builtin_amdgcn_cvt_pk_fp8_f32(fp8c(hv[4]), fp8c(hv[5]), w1, false); w1 = __builtin_amdgcn_cvt_pk_fp8_f32(fp8c(hv[6]), fp8c(hv[7]), w1, true);
                v2u w; w.x = (unsigned)w0; w.y = (unsigned)w1;
                *(v2u*)(base + (size_t)(ai * 128 + m * 16) * FF) = w;
            }
    }
};

constexpr int NPH = 20;
typedef const __attribute__((address_space(4))) Args* KArgP;
__device__ __forceinline__ KArgP kargs() { KArgP p = (KArgP)__builtin_amdgcn_kernarg_segment_ptr(); asm volatile("" : "+s"(p)); return p; }
#define MKCTX(C) Ctx C; { KArgP a_ = kargs(); C.lds = (LAS unsigned char*)lds_raw; { unsigned z_ = 0u; asm volatile("" : "+s"(z_)); C.tid = (wave << 6) | (int)__builtin_amdgcn_mbcnt_hi(~0u, __builtin_amdgcn_mbcnt_lo(~0u, z_)); } asm volatile("" : "+v"(C.tid)); __builtin_assume((unsigned)C.tid < 512u);   C.lane = C.tid & 63; C.wave = wave; C.G = (int)gridDim.x; C.blk = (int)blockIdx.x; \
    C.in_xp = a_->in[0]; C.in_xs = a_->in[1]; C.in_cp = a_->in[2]; C.in_cs = a_->in[3]; C.in_norm1 = a_->in[4]; C.in_norm2 = a_->in[5]; \
    C.in_adaw = a_->in[6]; C.in_adab = a_->in[7]; C.in_wqkv = a_->in[8]; C.in_qg = a_->in[9]; C.in_kg = a_->in[10]; C.in_rpb = a_->in[11]; \
    C.in_wo = a_->in[12]; C.in_win = a_->in[13]; C.in_wout = a_->in[14]; C.in_router = a_->in[15]; C.in_gate = a_->in[16]; C.in_up = a_->in[17]; C.in_down = a_->in[18]; \
    C.out = a_->out; C.ws = a_->ws; }

#ifndef PH_ONLY
#define PH_ONLY -1
#endif
#define IN(k) ((PH_ONLY < 0 || PH_ONLY == (k) || (PH_ONLY >= 100 && PH_ONLY - 100 == ((k) > 10 ? (k) - 9 : (k)))) && lo <= (k) && (k) < hi)
#define SEAM(k) do { if (IN(k) && IN((k) + 1)) xcd_barrier(bar); } while (0)
extern __shared__ __attribute__((aligned(16))) unsigned char lds_raw[];
template <int l> __device__ __forceinline__ void layer_phases(const int tid, const int wave, const int lo, const int hi, const XcdBarrier& bar) {
        if constexpr (l == 0) {
            if (IN(1)) { MKCTX(C); norm_rows_phase(C); p0_rest(C); } SEAM(1);
            if (IN(2)) {
                {
                    MKCTX(C); unsigned char* ws = C.ws;
                    Sched<0> S; S.init(NT / 256, 8, C.G, C.blk); S.A0 = (const char*)(ws + WS_H); S.B0 = (const char*)(ws + WS_BTQK); S.sA = 256 * D; S.sB = 256 * D; S.sE = 0;
                    EpiQK E{(bf16*)(ws + WS_Q), (bf16*)(ws + WS_K), C.in_qg, C.in_kg};
                    pg8::gemm_phase<EpiQK, Sched<0>, true, true>(C.lds, D, D, D, S, E, nullptr, C.tid);
                }
                {
                    MKCTX(C); unsigned char* ws = C.ws;
                    Sched<0> S; S.init(4, NT / 256, C.G, C.blk); S.A0 = (const char*)(ws + WS_BTV); S.B0 = (const char*)(ws + WS_H); S.sA = 256 * D; S.sB = 256 * D; S.sE = 0;
                    EpiVT E{(bf16*)(ws + WS_VT)};
                    pg8::gemm_phase<EpiVT, Sched<0>, true, true, false, true>(C.lds, D, D, D, S, E, nullptr, C.tid);
                }
            } SEAM(2);
            if (IN(3)) { MKCTX(C); attn_phase(C); __syncthreads(); } SEAM(3);
        } else {
            if (IN(11)) {
                MKCTX(C); unsigned char* ws = C.ws;
                Sched<4> S; S.init(4, NT / 256, C.G, C.blk); S.A0 = (const char*)(ws + WS_BTIN); S.B0 = (const char*)(ws + WS_H); S.sA = 256 * D * 2; S.sB = D * 2; S.sE = 0;
                EpiEO E{(bf16*)(ws + WS_VT2)};
                pg8::gemm_phase<EpiEO, Sched<4>, true, false, false, false, true>(C.lds, D * 2, D * 2, D * 2, S, E, nullptr, C.tid, (size_t)1024 * D * 2);
                f128_task(C);
                __syncthreads();
            } SEAM(11);
            if (IN(12)) {
                MKCTX(C); unsigned char* ws = C.ws;
                Sched<3> S; S.init(NB * 4, 4, C.G, C.blk); S.A0 = (const char*)(ws + WS_CS); S.B0 = (const char*)(ws + WS_VT2); S.sA = (size_t)256 * 1024 * 2; S.sB = (size_t)256 * 1024 * 2; S.sE = (size_t)512 * 1024 * 2;
                EpiPQ E{(bf16*)(ws + WS_H), (const float*)(ws + WS_F128)};
                pg8::gemm_phase<EpiPQ, Sched<3>, true, false, false, false, true>(C.lds, 2048, 2048, 2048, S, E, nullptr, C.tid);
                pq_nyq_task(C);
            } SEAM(12);
        }
        {
            const int pid = l == 0 ? 4 : 13;
            if (IN(pid)) {
                MKCTX(C); unsigned char* ws = C.ws;
                Sched<0> S; S.init(NT / 256, 4, C.G, C.blk); S.A0 = (const char*)(ws + WS_H); S.B0 = (const char*)(ws + (l == 0 ? WS_BTO : WS_BTOUT)); S.sA = 256 * D * 2; S.sB = 256 * D * 2; S.sE = 0;
                EpiRes E{C.in_xp, C.in_xs, (bf16*)(ws + WS_XB), (const float*)(ws + WS_MOD) + (size_t)l * NB * 6144 + 2 * 1024, l};
                pg8::gemm_phase<EpiRes, Sched<0>, true, false, false, false, true>(C.lds, D * 2, D * 2, D * 2, S, E, nullptr, C.tid);
            } SEAM(pid);
        }
        const int q0 = l == 0 ? 5 : 14;
        if (IN(q0)) { MKCTX(C); norm_router_mfma_phase(C, l); __syncthreads(); } SEAM(q0);
        if (IN(q0 + 1)) { MKCTX(C); if (C.blk < 32) topk_block(C);
            else moe_convert_range(C, l, C.ws + WS_BT1, C.ws + WS_BT2, (C.blk - 32) * NWAVES + C.wave, (C.G - 32) * NWAVES, 0, CV_ITEMS);
            __syncthreads(); } SEAM(q0 + 1);
        if (IN(q0 + 3)) {
            MKCTX(C); unsigned char* ws = C.ws;
            Sched<1> S; S.init(NSLOT / 256, 16, C.G, C.blk); S.A0 = (const char*)(ws + WS_H); S.B0 = (const char*)(ws + WS_BT1); S.sA = 0; S.sB = 256 * D; S.sE = (size_t)4096 * D;
            LAS unsigned* gtab = (LAS unsigned*)(C.lds + RING_BYTES);
            { const int* idx = (const int*)(ws + WS_IDX); LAS int* pmt = (LAS int*)(C.lds + RING_BYTES + 24 * 1024);
              if (C.tid < 24) { int pm = 0, pn = 0; (void)S.idx(C.tid, pm, pn); pmt[C.tid] = pm; }
              __syncthreads();
              int tk[12];
#pragma unroll
              for (int k = 0; k < 12; ++k) tk[k] = idx[pmt[2 * k + (C.tid >> 8)] * 256 + (C.tid & 255)];
#pragma unroll
              for (int k = 0; k < 12; ++k) gtab[(2 * k + (C.tid >> 8)) * 256 + (C.tid & 255)] = (unsigned)tk[k] * (unsigned)D; }
            __syncthreads();
            EpiAct E{ws + WS_ACT};
            pg8::gemm_phase<EpiAct, Sched<1>, true, true, true, false, false, 5>(C.lds, D, D, D, S, E, gtab, C.tid);
            __syncthreads();
        } SEAM(q0 + 3);
        if (IN(q0 + 4)) {
            MKCTX(C); unsigned char* ws = C.ws;
            Sched<1> S; S.init(NSLOT / 256, 4, C.G, C.blk); S.A0 = (const char*)(ws + WS_ACT); S.B0 = (const char*)(ws + WS_BT2); S.sA = (size_t)256 * FF; S.sB = (size_t)256 * FF; S.sE = (size_t)D * FF;
            EpiY8 E{ws + WS_Y};
            pg8::gemm_phase<EpiY8, Sched<1>, true, true, false, false, true, 5>(C.lds, FF, FF, FF, S, E, nullptr, C.tid);
        } SEAM(q0 + 4);
        if (IN(q0 + 5)) { MKCTX(C); combine_phase(C, l, l == 0); } if (l == 0) SEAM(q0 + 5);
    }

__global__ void __launch_bounds__(NWAVES * 64, 2) trunk_fwd(Args args) {
    const int tid = threadIdx.x, wave = __builtin_amdgcn_readfirstlane(tid >> 6);
    volatile LAS unsigned* MISC = (volatile LAS unsigned*)((LAS unsigned char*)lds_raw + MISC_OFF);
    if (tid < 64) MISC[tid] = 0u;
    __syncthreads();
    XcdBarrier bar; bar.bar = (unsigned*)(args.ws + WS_CTL) + CW_BAR; bar.x = 0; bar.st = MISC + 8; bar.t0 = tid == 0;
    if (args.use_bar) bar = xcd_barrier_post((unsigned*)(args.ws + WS_CTL) + CW_BAR, MISC + 8);
    const int lo = args.ph_lo, hi = args.ph_hi;

    if (IN(0)) { MKCTX(C); p0_prologue(C); } SEAM(0);
    layer_phases<0>(tid, wave, lo, hi, bar);
    layer_phases<1>(tid, wave, lo, hi, bar);
#undef IN
#undef SEAM
}

extern "C" void kernel_launch(void* const* d_in, const int* in_sizes, int n_in, void* d_out, int out_size, void* d_ws, size_t ws_size, hipStream_t stream) {
    static int grid = 0;
    if (grid == 0) {
        if (n_in != 19 || out_size != NT * D || ws_size < WS_END) { fprintf(stderr, "kernel_launch: unexpected shapes (n_in %d, out %d, ws %zu < %zu)\n", n_in, out_size, ws_size, (size_t)WS_END); grid = -1; return; }
        int dev = 0, cus = 0;
        if (hipGetDevice(&dev) != hipSuccess || hipDeviceGetAttribute(&cus, hipDeviceAttributeMultiprocessorCount, dev) != hipSuccess) { grid = -1; return; }
        if (hipFuncSetAttribute((const void*)trunk_fwd, hipFuncAttributeMaxDynamicSharedMemorySize, LDS_BYTES) != hipSuccess) { fprintf(stderr, "kernel_launch: hipFuncSetAttribute failed\n"); grid = -1; return; }
        int per_cu = 0;
        if (hipOccupancyMaxActiveBlocksPerMultiprocessor(&per_cu, (const void*)trunk_fwd, NWAVES * 64, LDS_BYTES) != hipSuccess || per_cu < 1) fprintf(stderr, "kernel_launch: occupancy query says %d\n", per_cu);
        (void)hipGetLastError();
        grid = 256;
        if (cus < 256) fprintf(stderr, "kernel_launch: %d CUs reported, the kernel needs 256 co-resident workgroups\n", cus);
    }
    if (grid < 0) return;
    (void)hipMemsetAsync((char*)d_ws + WS_CTL, 0, CTL_ZERO_BYTES, stream);
    Args a{};
    for (int i = 0; i < 19; ++i) a.in[i] = (const float*)d_in[i];
    a.out = (float*)d_out; a.ws = (unsigned char*)d_ws; a.pad = 0;
#if MK_N_LAUNCHES == 1
    a.ph_lo = 0; a.ph_hi = NPH; a.use_bar = 1;
    hipLaunchKernelGGL(trunk_fwd, dim3(grid), dim3(NWAVES * 64), LDS_BYTES, stream, a);
#else
    for (int p = 0; p < NPH; ++p) { const int reps = 1 + ((DUP_MASK >> p) & 1); for (int r = 0; r < reps; ++r) { a.ph_lo = p; a.ph_hi = p + 1; a.use_bar = 0; hipLaunchKernelGGL(trunk_fwd, dim3(grid), dim3(NWAVES * 64), LDS_BYTES, stream, a); } }
#endif
}
```

```cpp
#include <hip/hip_runtime.h>
#include <cstdio>
#include <cstdint>

#ifndef MK_N_LAUNCHES
#define MK_N_LAUNCHES 1
#endif
#ifndef DUP_MASK
#define DUP_MASK 0
#endif

namespace pg8 {
#define PG8_LAS __attribute__((address_space(3)))
typedef unsigned short bf16_t;
typedef short bf16x8 __attribute__((ext_vector_type(8)));
typedef float f32x4 __attribute__((ext_vector_type(4)));
typedef unsigned u32x4 __attribute__((ext_vector_type(4)));
constexpr int BM = 256, BK = 64, HALF = 128, HTB = HALF * BK * 2, STAGE_BYTES = 8 * HTB, NXCD = 8, WGM = 8;

__host__ __device__ __forceinline__ int lds_byte(int r, int c) { const int st = (r >> 4) * 2 + (c >> 5), rr = r & 15, cc = c & 31, ob = rr * 64 + cc * 2; return st * 1024 + (ob ^ (((ob >> 9) & 1) << 5)); }
__host__ __device__ __forceinline__ void stage_rc(int b, int& R, int& C) { const int st = b / 1024, sb = b % 1024, swz = sb ^ (((sb >> 9) & 1) << 5); R = (st >> 1) * 16 + swz / 64; C = (st & 1) * 32 + (swz % 64) / 2; }
__host__ __device__ __forceinline__ int perm32(int rho) { const int n = rho >> 4, i = rho & 15; return 8 * (i >> 2) + 4 * n + (i & 3); }

struct Unit { int pm, pn; const char* A; const char* B; };

struct OrderBase {
    int nM, nN, nwg, G, c;
    __device__ __forceinline__ void init(int nM_, int nN_, int G_, int c_) { nM = nM_; nN = nN_; nwg = nM * nN; G = G_; c = c_; }
    __device__ __forceinline__ bool idx(int i, int& pm, int& pn) const {
        const long L = (long)i * G + c; if (L >= nwg) return false;
        int wgid = (int)L; { const int q = nwg / NXCD, r = nwg % NXCD, xcd = wgid % NXCD, off = wgid / NXCD; wgid = (xcd < r ? xcd * (q + 1) : r * (q + 1) + (xcd - r) * q) + off; }
        const int nig = WGM * nN, gid = wgid / nig, fm = gid * WGM, gsz = (nM - fm) < WGM ? (nM - fm) : WGM;
        pm = fm + ((wgid % nig) % gsz); pn = (wgid % nig) / gsz; return true;
    }
};

__device__ __forceinline__ const char* uptr(const char* p) { const unsigned long long v = (unsigned long long)p; const unsigned lo = __builtin_amdgcn_readfirstlane((unsigned)v), hi = __builtin_amdgcn_readfirstlane((unsigned)(v >> 32)); return (const char*)(((unsigned long long)hi << 32) | lo); }
__device__ __forceinline__ unsigned cvt_pk_bf16(float lo, float hi) { unsigned r; asm volatile("v_cvt_pk_bf16_f32 %0, %1, %2" : "=v"(r) : "v"(lo), "v"(hi)); return r; }

typedef int i32x4 __attribute__((ext_vector_type(4)));
typedef int i32x8 __attribute__((ext_vector_type(8)));
__device__ __forceinline__ i32x8 cat8(bf16x8 lo, bf16x8 hi) { const i32x4 a = __builtin_bit_cast(i32x4, lo), b = __builtin_bit_cast(i32x4, hi); return __builtin_shufflevector(a, b, 0, 1, 2, 3, 4, 5, 6, 7); }
#define PG8_GOFF(unit, h, i) (gtab[(unit) * 256 + (h) * 128 + gri[i]] + gcb[i])
template <class Epi, class Sched, bool ALIGN_EPI = true, bool FP8 = false, bool GATHER = false, bool OWN_TID = false, bool PEEL = false>
__device__ __forceinline__ void gemm_phase(PG8_LAS unsigned char* lds, const int Kb, const int lda, const int ldb, const Sched& S, const Epi& E, const PG8_LAS unsigned* gtab, const int tid_in, const size_t hstepB_over = 0) {
    int tid = tid_in; if constexpr (OWN_TID) asm volatile("" : "+v"(tid));
    __builtin_assume((unsigned)tid < 512u);
    const int wid = __builtin_amdgcn_readfirstlane(tid >> 6), lane = tid & 63, wr = wid >> 2, wc = wid & 3, fr = lane & 15, fq = lane >> 4;
    const int nt = Kb / (BK * 2);
    unsigned voffA[2], voffB[2];
#pragma unroll
    for (int i = 0; i < 2; ++i) { int R, C; stage_rc(tid * 16 + i * 8192, R, C); const int Rb = Epi::PERM ? ((R & ~31) + perm32(R & 31)) : R;
        voffA[i] = (unsigned)(R * lda + C * 2); voffB[i] = (unsigned)(Rb * ldb + C * 2); }
    const size_t kstep = (size_t)(BK * 2);
    const size_t hstepA = (size_t)HALF * lda, hstepB = hstepB_over ? hstepB_over : (size_t)HALF * ldb;
    const unsigned ldsw = (unsigned)wid * 1024u;
    const int aoff = lds_byte(wr * 64 + fr, fq * 8), boff = lds_byte(wc * 32 + fr, fq * 8);
#define PG8_SA(b, h) (((b) * 2 + (h)) * HTB)
#define PG8_SB(b, h) ((4 + (b) * 2 + (h)) * HTB)
#define PG8_STAGE(bufoff, gbase, voff) do { _Pragma("unroll") for (int _i = 0; _i < 2; ++_i) \
        __builtin_amdgcn_global_load_lds((const unsigned*)((const char*)(gbase) + (voff)[_i]), (PG8_LAS unsigned*)(lds + (bufoff) + ldsw + _i * 8192), 16, 0, 0); } while (0)
#define PG8_STAGE_A(bufoff, gbase, h, usenext) do { if constexpr (GATHER) { const unsigned n0_ = PG8_GOFF(ui + 1, h, 0), n1_ = PG8_GOFF(ui + 1, h, 1), o0_ = (usenext) ? n0_ : gc[h][0], o1_ = (usenext) ? n1_ : gc[h][1];     \
            __builtin_amdgcn_global_load_lds((const unsigned*)((const char*)(gbase) + o0_), (PG8_LAS unsigned*)(lds + (bufoff) + ldsw), 16, 0, 0); \
            __builtin_amdgcn_global_load_lds((const unsigned*)((const char*)(gbase) + o1_), (PG8_LAS unsigned*)(lds + (bufoff) + ldsw + 8192), 16, 0, 0); } \
        else { PG8_STAGE(bufoff, (gbase) + (h) * hstepA, voffA); } } while (0)
#define PG8_LDA(dst, b, h) do { if constexpr (FP8) { _Pragma("unroll") for (int m = 0; m < 4; ++m) { const i32x4 lo_ = *(const PG8_LAS i32x4*)(lds + PG8_SA(b, h) + aoff + m * 2048), hi_ = *(const PG8_LAS i32x4*)(lds + PG8_SA(b, h) + aoff + m * 2048 + 1024); dst##8[m] = __builtin_shufflevector(lo_, hi_, 0, 1, 2, 3, 4, 5, 6, 7); } } \
        else { _Pragma("unroll") for (int m = 0; m < 4; ++m) _Pragma("unroll") for (int k = 0; k < 2; ++k) dst[m][k] = *(const PG8_LAS bf16x8*)(lds + PG8_SA(b, h) + aoff + m * 2048 + k * 1024); } } while (0)
#define PG8_LDB(dst, b, h) do { if constexpr (FP8) { _Pragma("unroll") for (int n = 0; n < 2; ++n) { const i32x4 lo_ = *(const PG8_LAS i32x4*)(lds + PG8_SB(b, h) + boff + n * 2048), hi_ = *(const PG8_LAS i32x4*)(lds + PG8_SB(b, h) + boff + n * 2048 + 1024); dst##8[n] = __builtin_shufflevector(lo_, hi_, 0, 1, 2, 3, 4, 5, 6, 7); } } \
        else { _Pragma("unroll") for (int n = 0; n < 2; ++n) _Pragma("unroll") for (int k = 0; k < 2; ++k) dst[n][k] = *(const PG8_LAS bf16x8*)(lds + PG8_SB(b, h) + boff + n * 2048 + k * 1024); } } while (0)
#define PG8_MMA(ai, bj, At, Bt, Z) do { __builtin_amdgcn_s_setprio(1); \
        if constexpr (FP8) { _Pragma("unroll") for (int m = 0; m < 4; ++m) _Pragma("unroll") for (int n = 0; n < 2; ++n) \
            acc[ai][bj][m][n] = __builtin_amdgcn_mfma_scale_f32_16x16x128_f8f6f4(Bt##8[n], At##8[m], (Z) ? (f32x4){0.f, 0.f, 0.f, 0.f} : acc[ai][bj][m][n], 0, 0, 0, 0x7f7f7f7f, 0, 0x7f7f7f7f); } \
        else { _Pragma("unroll") for (int m = 0; m < 4; ++m) _Pragma("unroll") for (int n = 0; n < 2; ++n) _Pragma("unroll") for (int k = 0; k < 2; ++k) \
            acc[ai][bj][m][n] = __builtin_amdgcn_mfma_f32_16x16x32_bf16(Bt[n][k], At[m][k], ((Z) && k == 0) ? (f32x4){0.f, 0.f, 0.f, 0.f} : acc[ai][bj][m][n], 0, 0, 0); } \
        __builtin_amdgcn_s_setprio(0); } while (0)
#define PG8_WAIT_V(n) asm volatile("s_waitcnt vmcnt(" #n ")" ::: "memory")
#define PG8_WAIT_L(n) asm volatile("s_waitcnt lgkmcnt(" #n ")" ::: "memory")
#define PG8_BAR __builtin_amdgcn_s_barrier()
#define PG8_SCHED __builtin_amdgcn_sched_barrier(0)
    Unit cur, nxt; int ui = 0;
    if (!S.next(0, cur)) return;
    f32x4 acc[2][2][4][2];
    if constexpr (!PEEL)
#pragma unroll
    for (int a = 0; a < 2; ++a)
#pragma unroll
        for (int b = 0; b < 2; ++b)
#pragma unroll
            for (int m = 0; m < 4; ++m)
#pragma unroll
                for (int n = 0; n < 2; ++n) acc[a][b][m][n] = (f32x4){0.f, 0.f, 0.f, 0.f};
    bf16x8 At[4][2], B0[2][2], B1[2][2];
    i32x8 At8[4], B08[2], B18[2];
    const char* cA = uptr(cur.A); const char* cB = uptr(cur.B);
    unsigned gc[2][2];
    int gri[2]; unsigned gcb[2];
    if constexpr (GATHER) {
#pragma unroll
        for (int i = 0; i < 2; ++i) { int R, C; stage_rc(tid * 16 + i * 8192, R, C); gri[i] = R; gcb[i] = (unsigned)(C * 2); }
#pragma unroll
        for (int h = 0; h < 2; ++h)
#pragma unroll
            for (int i = 0; i < 2; ++i) gc[h][i] = PG8_GOFF(0, h, i);
    }
    PG8_STAGE(PG8_SB(0, 0), cB, voffB); PG8_STAGE(PG8_SB(0, 1), cB + hstepB, voffB); PG8_STAGE_A(PG8_SA(0, 0), cA, 0, false); PG8_STAGE_A(PG8_SA(0, 1), cA, 1, false);
    if (wr == 1) PG8_BAR;
    PG8_WAIT_V(2); PG8_BAR;
    PG8_STAGE(PG8_SB(1, 0), cB + kstep, voffB); PG8_STAGE_A(PG8_SA(1, 0), cA + kstep, 0, false); PG8_STAGE(PG8_SB(1, 1), cB + hstepB + kstep, voffB);
    PG8_WAIT_V(6); PG8_BAR;
    for (;;) {
        const bool has_next = S.next(ui + 1, nxt);
        const char* nA = has_next ? nxt.A : cA; const char* nB = has_next ? nxt.B : cB;
#define PG8_ITER(t, Z) do { \
            const bool last = ((t) == nt - 2); const bool usenext = last && has_next;     \
            if constexpr (GATHER) { asm volatile("" : "+v"(voffB[0]), "+v"(voffB[1])); asm volatile("" : "+v"(gc[0][0]), "+v"(gc[0][1]), "+v"(gc[1][0]), "+v"(gc[1][1])); } \
            else asm volatile("" : "+v"(voffA[0]), "+v"(voffA[1]), "+v"(voffB[0]), "+v"(voffB[1]));     \
            const char* a1 = cA + (size_t)((t) + 1) * kstep; \
            const char* a2 = last ? nA : cA + (size_t)((t) + 2) * kstep; const char* b2 = last ? nB : cB + (size_t)((t) + 2) * kstep; \
            const char* a3 = a2 + kstep; const char* b3 = b2 + kstep; \
            a1 = uptr(a1); a2 = uptr(a2); a3 = uptr(a3); b2 = uptr(b2); b3 = uptr(b3);     \
  \
            PG8_LDB(B0, 0, 0); PG8_LDB(B1, 0, 1); PG8_SCHED; PG8_LDA(At, 0, 0); PG8_STAGE_A(PG8_SA(1, 1), a1, 1, false); \
            PG8_WAIT_V(8); PG8_WAIT_L(0); PG8_BAR; PG8_MMA(0, 0, At, B0, Z); PG8_MMA(0, 1, At, B1, Z); PG8_BAR; PG8_SCHED; \
  \
            PG8_LDA(At, 0, 1); PG8_STAGE(PG8_SB(0, 0), b2, voffB); PG8_STAGE(PG8_SB(0, 1), b2 + hstepB, voffB); PG8_STAGE_A(PG8_SA(0, 0), a2, 0, usenext); \
            PG8_WAIT_V(8); PG8_WAIT_L(0); PG8_BAR; PG8_MMA(1, 0, At, B0, Z); PG8_MMA(1, 1, At, B1, Z); PG8_BAR; PG8_SCHED; \
  \
            PG8_LDB(B0, 1, 0); PG8_LDB(B1, 1, 1); PG8_SCHED; PG8_LDA(At, 1, 0); PG8_STAGE_A(PG8_SA(0, 1), a2, 1, usenext); \
            PG8_WAIT_V(8); PG8_WAIT_L(0); PG8_BAR; PG8_MMA(0, 0, At, B0, 0); PG8_MMA(0, 1, At, B1, 0); PG8_BAR; PG8_SCHED; \
  \
            PG8_LDA(At, 1, 1); PG8_STAGE(PG8_SB(1, 0), b3, voffB); PG8_STAGE(PG8_SB(1, 1), b3 + hstepB, voffB); PG8_STAGE_A(PG8_SA(1, 0), a3, 0, usenext); \
            PG8_WAIT_V(8); PG8_WAIT_L(0); PG8_BAR; PG8_MMA(1, 0, At, B0, 0); PG8_MMA(1, 1, At, B1, 0); PG8_BAR; PG8_SCHED; \
        } while (0)
        if constexpr (PEEL) { PG8_ITER(0, 1);
#pragma nounroll
            for (int t = 2; t < nt; t += 2) PG8_ITER(t, 0); }
        else {
#pragma nounroll
            for (int t = 0; t < nt; t += 2) PG8_ITER(t, 0); }
        if constexpr (ALIGN_EPI) { if (wr == 0) PG8_BAR; }
        E(acc, cur, wr, wc, fr, fq);
        if (!has_next) break;
        if constexpr (!PEEL)
#pragma unroll
        for (int a = 0; a < 2; ++a)
#pragma unroll
            for (int b = 0; b < 2; ++b)
#pragma unroll
                for (int m = 0; m < 4; ++m)
#pragma unroll
                    for (int n = 0; n < 2; ++n) { if constexpr (GATHER) acc[a][b][m][n] = *(const volatile PG8_LAS f32x4*)(lds + 158784);
                        else acc[a][b][m][n] = (f32x4){0.f, 0.f, 0.f, 0.f}; }
        cur = nxt; cA = nA; cB = nB; ++ui;
        if constexpr (GATHER) {
#pragma unroll
            for (int h = 0; h < 2; ++h)
#pragma unroll
                for (int i = 0; i < 2; ++i) gc[h][i] = PG8_GOFF(ui, h, i);
        }
        if constexpr (ALIGN_EPI) { if (wr == 1) PG8_BAR; }
    }
    PG8_WAIT_V(0);
    if constexpr (!ALIGN_EPI) { if (wr == 0) PG8_BAR; }
    PG8_BAR;
#undef PG8_SA
#undef PG8_SB
#undef PG8_STAGE
#undef PG8_STAGE_A
#undef PG8_LDA
#undef PG8_LDB
#undef PG8_MMA
#undef PG8_ITER
#undef PG8_WAIT_V
#undef PG8_WAIT_L
#undef PG8_BAR
#undef PG8_SCHED
}
}

#define LAS __attribute__((address_space(3)))
typedef unsigned short bf16;
typedef unsigned v4u __attribute__((ext_vector_type(4)));
typedef unsigned v2u __attribute__((ext_vector_type(2)));
typedef float f32x4 __attribute__((ext_vector_type(4)));
typedef short bf16x8 __attribute__((ext_vector_type(8)));
#define LDS_WAIT() asm volatile("s_waitcnt lgkmcnt(0)" ::: "memory")
#define VM_WAIT() asm volatile("s_waitcnt vmcnt(0)" ::: "memory")
__device__ __forceinline__ unsigned f2bf(float f) { unsigned u = __builtin_bit_cast(unsigned, f); return (u + 0x7fffu + ((u >> 16) & 1u)) >> 16; }
__device__ __forceinline__ unsigned pk2(float lo, float hi) { return f2bf(lo) | (f2bf(hi) << 16); }
typedef __bf16 bf16x2_t __attribute__((ext_vector_type(2)));
__device__ __forceinline__ unsigned cvt2bf(float lo, float hi) { bf16x2_t v; v.x = (__bf16)lo; v.y = (__bf16)hi; return __builtin_bit_cast(unsigned, v); }
__device__ __forceinline__ float bf_lo(unsigned w) { return __builtin_bit_cast(float, w << 16); }
__device__ __forceinline__ float bf_hi(unsigned w) { return __builtin_bit_cast(float, w & 0xffff0000u); }
__device__ __forceinline__ float fp8c(float x) { return __builtin_amdgcn_fmed3f(x, -448.0f, 448.0f); }
__device__ __forceinline__ float wave_sum(float v) {
#pragma unroll
    for (int o = 1; o < 64; o <<= 1) v += __shfl_xor(v, o);
    return v;
}

#define XB_TMO      128
#define XB_XCNT(j)  (256  + 64 * (j))
#define XB_XSUB(j)  (1280 + 64 * (j))
#define XB_XGEN(j)  (2304 + 64 * (j))
#define XB_TOP      3328
#define XB_TOPGEN   3392
#define XCD_BAR_WORDS 3456
#define XB_SPIN_CAP (1u << 22)

__device__ __forceinline__ unsigned xb_ld(unsigned* p)              { return __hip_atomic_load(p, __ATOMIC_RELAXED, __HIP_MEMORY_SCOPE_AGENT); }
__device__ __forceinline__ unsigned xb_add(unsigned* p, unsigned v) { return __hip_atomic_fetch_add(p, v, __ATOMIC_RELAXED, __HIP_MEMORY_SCOPE_AGENT); }
__device__ __forceinline__ unsigned xb_xcc_id() { return (unsigned)__builtin_amdgcn_s_getreg((3 << 11) | 20) & 0xFu; }
#define XB_SPIN(cond, bar) do { unsigned _sp = 0; while (cond) { __builtin_amdgcn_s_sleep(1); \
    if ((++_sp & 255u) == 0u) { if (xb_ld(&(bar)[XB_TMO])) break; if (_sp > XB_SPIN_CAP) { atomicAdd(&(bar)[XB_TMO], 1u); break; } } } } while (0)

struct XcdBarrier { unsigned* bar; unsigned x; volatile LAS unsigned* st; bool t0; };

__device__ __forceinline__ XcdBarrier xcd_barrier_post(unsigned* bar, volatile LAS unsigned* st) {
    XcdBarrier b; b.bar = bar; b.x = xb_xcc_id(); b.st = st; b.t0 = threadIdx.x == 0;
    if (b.t0) (void)xb_add(&bar[XB_XCNT(b.x)], 1u);
    return b;
}
__device__ __forceinline__ void xcd_barrier_complete(unsigned* bar, unsigned x, unsigned& nloc, unsigned& nx) {
    const unsigned G = gridDim.x * gridDim.y * gridDim.z;
    unsigned sum, cnt, mine, sp = 0u;
    for (;;) {
        sum = 0u; cnt = 0u; mine = 0u;
#pragma unroll
        for (unsigned j = 0; j < 16; ++j) { const unsigned c = xb_ld(&bar[XB_XCNT(j)]); sum += c; cnt += (c > 0u) ? 1u : 0u; mine = (j == x) ? c : mine; }
        if (sum == G) break;
        __builtin_amdgcn_s_sleep(1);
        if ((++sp & 255u) == 0u) { if (xb_ld(&bar[XB_TMO])) break; if (sp > XB_SPIN_CAP) { atomicAdd(&bar[XB_TMO], 1u); break; } }
    }
    nloc = mine > 0u ? mine : 1u; nx = cnt > 0u ? cnt : 1u;
}
__device__ __forceinline__ void xcd_barrier(const XcdBarrier& b) {
    asm volatile("s_waitcnt vmcnt(0)" ::: "memory");
    __syncthreads();
    if (b.t0) {
        unsigned* bar = b.bar;
        __builtin_amdgcn_s_waitcnt(0);
        unsigned nloc = b.st[0], nx = b.st[1];
        if (nloc == 0u) { xcd_barrier_complete(bar, b.x, nloc, nx); b.st[0] = nloc; b.st[1] = nx; }
        const unsigned old = xb_add(&bar[XB_XSUB(b.x)], 1u);
        const unsigned gen = old / nloc;
        if (old + 1u == (gen + 1u) * nloc) {
            __builtin_amdgcn_fence(__ATOMIC_RELEASE, "agent");
            asm volatile("s_waitcnt vmcnt(0)" ::: "memory");
            const unsigned og = xb_add(&bar[XB_TOP], 1u);
            const unsigned tg = og / nx;
            if (og + 1u == (tg + 1u) * nx) xb_add(&bar[XB_TOPGEN], 1u);
            else XB_SPIN(xb_ld(&bar[XB_TOPGEN]) == tg, bar);
            __builtin_amdgcn_fence(__ATOMIC_ACQUIRE, "agent");
            xb_add(&bar[XB_XGEN(b.x)], 1u);
            asm volatile("s_waitcnt vmcnt(0)" ::: "memory");
        } else {
            XB_SPIN(xb_ld(&bar[XB_XGEN(b.x)]) == gen, bar);
            __builtin_amdgcn_fence(__ATOMIC_ACQUIRE, "agent");
            asm volatile("s_waitcnt vmcnt(0)" ::: "memory");
        }
    }
    __syncthreads();
}

constexpr int NWAVES = 8;
constexpr int D = 1024, NT = 49152, NP = 32768, TSEQ = 2048, NB = 24, NBP = 16;
constexpr int NE = 16, FF = 2048, CAP_P = 4096, CAP_S = 2048, NSLOT = 98304, SLOT_S0 = 65536;
constexpr int NHEAD = 16, HD = 64;
constexpr float EPS = 1e-6f;

constexpr size_t MiB = 1u << 20;
constexpr size_t WS_CTL = 0, CTL_ZERO_BYTES = 64 * 1024;
constexpr size_t WS_MOD = 1 * MiB;
constexpr size_t WS_SHIFT = 2 * MiB + 512 * 1024;
constexpr size_t WS_RPT = 2 * MiB + 576 * 1024;
constexpr size_t WS_IDX = 3 * MiB;
constexpr size_t WS_AFF = 4 * MiB;
constexpr size_t WS_SMAP = 7 * MiB;
constexpr size_t WS_BTQK = 10 * MiB;
constexpr size_t WS_BTV = 14 * MiB;
constexpr size_t WS_BTO = 16 * MiB;
constexpr size_t WS_BTIN = 18 * MiB;
constexpr size_t WS_V128 = 20 * MiB;
constexpr size_t WS_F128 = 21 * MiB;
constexpr size_t WS_WN = 21 * MiB + 896 * 1024;
constexpr size_t WS_BTOUT = 22 * MiB;
constexpr size_t WS_CS = 24 * MiB;
constexpr size_t WS_BT1 = 40 * MiB;
constexpr size_t WS_BT2 = 168 * MiB;
constexpr size_t WS_H = 232 * MiB;
constexpr size_t WS_S = 328 * MiB;
constexpr size_t WS_Q = WS_S, WS_K = WS_S + 96 * MiB, WS_VT = WS_S + 192 * MiB;
constexpr size_t WS_XE = WS_S, WS_Y = WS_S, WS_ACT = WS_S + 192 * MiB;
constexpr size_t WS_XB = WS_S + 384 * MiB;
constexpr size_t WS_VT2 = WS_S;
constexpr size_t WS_END = WS_S + 576 * MiB;
constexpr int CW_BAR = 1024;

constexpr int RING_BYTES = 131072;
constexpr int LDS_BYTES = 159744;
constexpr int MISC_OFF = 158720;
static_assert(MISC_OFF + 64 == 158784, "gemm_phase reads its 16 zero bytes at MISC_OFF + 64");

struct Args {
    const float* in[19]; float* out; unsigned char* ws; int ph_lo, ph_hi, use_bar, pad;
};

struct Ctx {
    LAS unsigned char* lds; int tid, lane, wave, G, blk;
    const float *in_xp, *in_xs, *in_cp, *in_cs, *in_norm1, *in_norm2, *in_adaw, *in_adab, *in_wqkv, *in_qg, *in_kg, *in_rpb, *in_wo, *in_win, *in_wout, *in_router, *in_gate, *in_up, *in_down;
    float* out; unsigned char* ws;
};

__device__ __forceinline__ void transpose_item(const float* W, int ldw, int k0, int n0, bf16* dst, int ldd, LAS float* scr, int lane) {
#pragma unroll 8
    for (int i = 0; i < 32; ++i) { const int kk = 2 * i + (lane >> 5); scr[kk * 33 + (lane & 31)] = W[(size_t)(k0 + kk) * ldw + n0 + (lane & 31)]; }
    LDS_WAIT(); asm volatile("" ::: "memory");
    const int c = lane & 7;
#pragma unroll
    for (int j = 0; j < 4; ++j) { const int n = (lane >> 3) + 8 * j; const LAS float* s = scr + (8 * c) * 33 + n;
        v4u o; o.x = pk2(s[0 * 33], s[1 * 33]); o.y = pk2(s[2 * 33], s[3 * 33]); o.z = pk2(s[4 * 33], s[5 * 33]); o.w = pk2(s[6 * 33], s[7 * 33]);
        *(v4u*)(dst + (size_t)n * ldd + k0 + 8 * c) = o; }
    LDS_WAIT(); asm volatile("" ::: "memory");
}

__device__ __forceinline__ const float* c_row(const Ctx& C, int b) { return b < NBP ? C.in_cp + (size_t)b * D : C.in_cs + (size_t)(b - NBP) * D; }
__device__ __forceinline__ float silu_f(float x) { return x / (1.0f + __expf(-x)); }

__device__ __forceinline__ void p0_prologue(const Ctx& C) {
    const int tid = C.tid, lane = C.lane, wave = C.wave, blk = C.blk;
    float* modv = (float*)(C.ws + WS_MOD);
    if (blk < 192) {
        const int l = blk / 96, jc = blk % 96;
        LAS float* sc = (LAS float*)C.lds;
        LAS float* red = (LAS float*)(C.lds + 98304);
        for (int i0 = tid; i0 < NB * D; i0 += 512 * 8) { float cv[8];
#pragma unroll
            for (int u = 0; u < 8; ++u) { const int i = i0 + 512 * u; cv[u] = c_row(C, i >> 10)[i & 1023]; }
#pragma unroll
            for (int u = 0; u < 8; ++u) sc[i0 + 512 * u] = silu_f(cv[u]); }
        __syncthreads();
        const float* W = C.in_adaw + (size_t)l * D * 6144 + jc * 64 + lane;
        float acc[NB];
#pragma unroll
        for (int b = 0; b < NB; ++b) acc[b] = 0.f;
        for (int k16 = wave * 128; k16 < wave * 128 + 128; k16 += 16) {
            float w[16];
#pragma unroll
            for (int q = 0; q < 16; ++q) w[q] = W[(size_t)(k16 + q) * 6144];
#pragma unroll
            for (int q4 = 0; q4 < 4; ++q4)
#pragma unroll
                for (int b = 0; b < NB; ++b) { const f32x4 s = *(const LAS f32x4*)(sc + b * 1024 + k16 + 4 * q4); acc[b] += s.x * w[4 * q4] + s.y * w[4 * q4 + 1] + s.z * w[4 * q4 + 2] + s.w * w[4 * q4 + 3]; }
        }
#pragma unroll
        for (int b = 0; b < NB; ++b) red[(wave * NB + b) * 64 + lane] = acc[b];
        __syncthreads();
        for (int i = tid; i < NB * 64; i += 512) { const int b = i >> 6, j = i & 63; float s = 0.f;
#pragma unroll
            for (int w = 0; w < 8; ++w) s += red[(w * NB + b) * 64 + j];
            modv[((size_t)l * NB + b) * 6144 + jc * 64 + j] = s + C.in_adab[l * 6144 + jc * 64 + j]; }
        __syncthreads();
    }
}
__device__ __forceinline__ void transpose_fp8_item(const float* W, int ldw, int k0, int n0, unsigned char* dst, int ldd, LAS unsigned char* scr, int lane, float scale);
__device__ __forceinline__ void p0_rest(const Ctx& C) {
    const int tid = C.tid, lane = C.lane, wave = C.wave, blk = C.blk;
    {
        const int kt = blk >> 4, g = (blk >> 2) & 3, kq = blk & 3;
        LAS float* wt = (LAS float*)C.lds;
        LAS float* twc = (LAS float*)(C.lds + 64 * 257 * 4);
        LAS float* tws = twc + 256;
        const float* Win = C.in_win;
        for (int i0 = tid; i0 < 64 * 256; i0 += 512 * 8) { float wv[8];
#pragma unroll
            for (int u = 0; u < 8; ++u) { const int i = i0 + 512 * u; wv[u] = Win[(size_t)(kt * 64 + (i >> 8)) * D + g * 256 + (i & 255)]; }
#pragma unroll
            for (int u = 0; u < 8; ++u) { const int i = i0 + 512 * u; wt[(i >> 8) * 257 + (i & 255)] = wv[u]; } }
        if (tid < 256) { float s, c; sincospif((float)tid * (1.0f / 128.0f), &s, &c); twc[tid] = c * 0.0625f; tws[tid] = s * 0.0625f; }
        __syncthreads();
        const int kk = tid & 63, k2b = kq * 32 + wave * 4;
        float ar[4], ai[4];
#pragma unroll
        for (int q = 0; q < 4; ++q) { ar[q] = 0.f; ai[q] = 0.f; }
        float an = 0.f;
#pragma unroll 4
        for (int c = 0; c < 256; ++c) {
            const float w = wt[kk * 257 + c];
            an += (c & 1) ? -w : w;
#pragma unroll
            for (int q = 0; q < 4; ++q) { const int m = ((k2b + q) * c) & 255; ar[q] += w * twc[m]; ai[q] -= w * tws[m]; }
        }
        bf16* Bt = (bf16*)(C.ws + WS_BTIN);
#pragma unroll
        for (int q = 0; q < 4; ++q) {
            const int vc = g * 128 + k2b + q;
            Bt[(size_t)vc * D + kt * 64 + kk] = (bf16)f2bf(ar[q]);
            Bt[(size_t)(512 + vc) * D + kt * 64 + kk] = (bf16)f2bf(ai[q]);
        }
        if (kq == 0 && wave == 0) ((float*)(C.ws + WS_WN))[g * D + kt * 64 + kk] = an * 0.0625f;
        __syncthreads();
    }
    for (int i = blk * 512 + tid; i < NHEAD * 3840; i += C.G * 512) { const int h = i / 3840, r = i - h * 3840, k = r & 63, drow = (r >> 6) % 15, sft = r / 960; int dc = k + sft - 16; dc = dc < 0 ? 0 : (dc > 30 ? 30 : dc);
        ((float*)(C.ws + WS_RPT))[i] = C.in_rpb[h * 465 + drow * 31 + dc] * 1.4426950408889634f; }
    if (blk == 255 && wave == 7) {
        float gq = fabsf(C.in_qg[lane]), gk = fabsf(C.in_kg[lane]), bm = 0.f;
        for (int i0 = lane; i0 < NHEAD * 465; i0 += 64 * 8) { float rv[8];
#pragma unroll
            for (int u = 0; u < 8; ++u) { const int i = i0 + 64 * u; rv[u] = i < NHEAD * 465 ? fabsf(C.in_rpb[i]) : 0.f; }
#pragma unroll
            for (int u = 0; u < 8; ++u) bm = fmaxf(bm, rv[u]); }
#pragma unroll
        for (int o = 1; o < 64; o <<= 1) { gq = fmaxf(gq, __shfl_xor(gq, o)); gk = fmaxf(gk, __shfl_xor(gk, o)); bm = fmaxf(bm, __shfl_xor(bm, o)); }
        if (lane == 0) *(float*)(C.ws + WS_SHIFT) = 8.0f * 1.03f * gq * gk + bm;
    }
    {
        LAS float* scr = (LAS float*)(C.lds + wave * 16384);
        const int gw = blk * NWAVES + wave, NGW = C.G * NWAVES;
        constexpr int I_QKV = 8 * 96, I_O = 16 * 32, I_OUT = 16 * 32, I_CS = 1024;
        for (int it = gw; it < I_QKV + I_O + I_OUT + I_CS; it += NGW) {
            int r = it;
            if (r < I_QKV) {
                const int kb = r / 96, nb = r % 96, n0 = nb * 32;
                if (n0 < 2048) {
                    const int sec = n0 >> 10, head = (n0 >> 6) & 15, d0 = n0 & 63;
                    const int row = 256 * (sec * 4 + (head >> 2)) + 128 * (d0 >> 5) + 32 * (head & 3);
                    transpose_fp8_item(C.in_wqkv, 3072, kb * 128, n0, C.ws + WS_BTQK + (size_t)row * D, D, (LAS unsigned char*)scr, lane, 32.0f);
                } else transpose_fp8_item(C.in_wqkv, 3072, kb * 128, n0, C.ws + WS_BTV + (size_t)(n0 - 2048) * D, D, (LAS unsigned char*)scr, lane, 32.0f);
                continue; }
            r -= I_QKV;
            if (r < I_O) { const int kb = r / 32, nb = r % 32; transpose_item(C.in_wo, D, kb * 64, nb * 32, (bf16*)(C.ws + WS_BTO) + (size_t)(nb * 32) * D, D, scr, lane); continue; }
            r -= I_O;
            if (r < I_OUT) {
                const int kb = r / 32, nb = r % 32, kk0 = kb * 64, n0 = nb * 32, part = kk0 >> 9, g = (kk0 >> 7) & 3, k20 = kk0 & 127;
                const float* W = C.in_wout;
#pragma unroll 8
                for (int i = 0; i < 32; ++i) { const int kl = 2 * i + (lane >> 5), k2 = k20 + kl, n = n0 + (lane & 31);
                    const float t1 = W[(size_t)(g * 256 + k2) * D + n], t2 = W[(size_t)(g * 256 + (k2 ? 256 - k2 : 128)) * D + n];
                    scr[kl * 33 + (lane & 31)] = part == 0 ? (k2 ? t1 + t2 : t1) : (k2 ? t1 - t2 : t2); }
                LDS_WAIT(); asm volatile("" ::: "memory");
                const int c = lane & 7; bf16* dst = (bf16*)(C.ws + WS_BTOUT) + (size_t)n0 * D;
#pragma unroll
                for (int j = 0; j < 4; ++j) { const int n = (lane >> 3) + 8 * j; const LAS float* s = scr + (8 * c) * 33 + n;
                    v4u o; o.x = pk2(s[0 * 33], s[1 * 33]); o.y = pk2(s[2 * 33], s[3 * 33]); o.z = pk2(s[4 * 33], s[5 * 33]); o.w = pk2(s[6 * 33], s[7 * 33]);
                    *(v4u*)(dst + (size_t)n * D + kk0 + 8 * c) = o; }
                LDS_WAIT(); asm volatile("" ::: "memory");
                continue; }
            r -= I_OUT;
            {
                const int k1 = r; bf16* cs = (bf16*)(C.ws + WS_CS);
                const float sc = 0.022097086912079608f;
#pragma unroll 2
                for (int ch = 0; ch < 4; ++ch) {
                    const int t0 = ch * 512 + lane * 8, part = t0 >> 10; float v[8];
#pragma unroll
                    for (int e = 0; e < 8; ++e) { const int t = (t0 & 1023) + e; const int p = (k1 * t) & 2047; float s, c; sincospif((float)p * (1.0f / 1024.0f), &s, &c); v[e] = (part ? s : c) * sc; }
                    v4u o; o.x = pk2(v[0], v[1]); o.y = pk2(v[2], v[3]); o.z = pk2(v[4], v[5]); o.w = pk2(v[6], v[7]);
                    *(v4u*)(cs + ((size_t)((part * 2 + (k1 & 1)) * 512 + (k1 >> 1)) * 1024 + (t0 & 1023))) = o;
                }
            }
        }
    }
}

#define COLJ(j, lane) ((((j) >> 1) << 9) + 8 * (lane) + (((j) & 1) << 2))
struct RowMod { f32x4 a[4], b[4]; int bcur; };
__device__ __forceinline__ void load_rowmod(RowMod& M, const float* modl  , const float* gain, int b, int slot_sh, int lane) {
    const float* mb = modl + (size_t)b * 6144;
#pragma unroll
    for (int j = 0; j < 4; ++j) { const int col = COLJ(j, lane);
        const f32x4 g = *(const f32x4*)(gain + col), sc = *(const f32x4*)(mb + (slot_sh + 1) * 1024 + col), sh = *(const f32x4*)(mb + slot_sh * 1024 + col);
        M.a[j] = g * (sc + 1.0f); M.b[j] = sh; }
    M.bcur = b;
}

__device__ __forceinline__ void store_row_bf16(bf16* orow, const f32x4 (&o)[4], int lane) {
#pragma unroll
    for (int jp = 0; jp < 2; ++jp) { v4u w; w.x = cvt2bf(o[2 * jp].x, o[2 * jp].y); w.y = cvt2bf(o[2 * jp].z, o[2 * jp].w); w.z = cvt2bf(o[2 * jp + 1].x, o[2 * jp + 1].y); w.w = cvt2bf(o[2 * jp + 1].z, o[2 * jp + 1].w); *(v4u*)(orow + 512 * jp + 8 * lane) = w; }
}

__device__ __forceinline__ void load_row_bf16(const bf16* row, f32x4 (&v)[4], int lane) {
#pragma unroll
    for (int jp = 0; jp < 2; ++jp) { const v4u w = *(const v4u*)(row + 512 * jp + 8 * lane);
        v[2 * jp] = (f32x4){bf_lo(w.x), bf_hi(w.x), bf_lo(w.y), bf_hi(w.y)}; v[2 * jp + 1] = (f32x4){bf_lo(w.z), bf_hi(w.z), bf_lo(w.w), bf_hi(w.w)}; }
}
constexpr int TB = 4, TOK_PER_BLK = NT / 256, TOK_PER_WAVE = TOK_PER_BLK / NWAVES;
__device__ __forceinline__ void sumsq4(const f32x4 (&v)[TB][4], float (&rinv)[TB]) {
    float ss[TB];
#pragma unroll
    for (int q = 0; q < TB; ++q) { ss[q] = 0.f;
#pragma unroll
        for (int j = 0; j < 4; ++j) ss[q] += (v[q][j].x * v[q][j].x + v[q][j].y * v[q][j].y) + (v[q][j].z * v[q][j].z + v[q][j].w * v[q][j].w); }
#pragma unroll
    for (int o = 1; o < 64; o <<= 1)
#pragma unroll
        for (int q = 0; q < TB; ++q) ss[q] += __shfl_xor(ss[q], o);
#pragma unroll
    for (int q = 0; q < TB; ++q) rinv[q] = 1.0f / sqrtf(ss[q] * (1.0f / D) + EPS);
}
__device__ __forceinline__ void norm_rows_phase(const Ctx& C) {
    const float* modl = (const float*)(C.ws + WS_MOD);
    const float* gain = C.in_norm1;
    unsigned char* H8 = C.ws + WS_H;
    RowMod M; M.bcur = -1;
    const int lane = C.lane;
    for (int i = 0; i < TOK_PER_WAVE / TB; ++i) {
        const int tokb = C.blk * TOK_PER_BLK + C.wave * TOK_PER_WAVE + TB * i, b = tokb >> 11;
        if (b != M.bcur) load_rowmod(M, modl, gain, b, 0, lane);
        const float* xr = tokb < NP ? C.in_xp + (size_t)tokb * D : C.in_xs + (size_t)(tokb - NP) * D;
        f32x4 v[TB][4]; float rinv[TB];
#pragma unroll
        for (int q = 0; q < TB; ++q)
#pragma unroll
            for (int j = 0; j < 4; ++j) v[q][j] = __builtin_nontemporal_load((const f32x4*)(xr + q * D + COLJ(j, lane)));
        sumsq4(v, rinv);
#pragma unroll
        for (int q = 0; q < TB; ++q) {
#pragma unroll
            for (int j = 0; j < 4; ++j) v[q][j] = v[q][j] * rinv[q] * M.a[j] + M.b[j];
#pragma unroll
            for (int jp = 0; jp < 2; ++jp) { int w0 = 0, w1 = 0;
                w0 = __builtin_amdgcn_cvt_pk_fp8_f32(fp8c(v[q][2 * jp].x), fp8c(v[q][2 * jp].y), w0, false); w0 = __builtin_amdgcn_cvt_pk_fp8_f32(fp8c(v[q][2 * jp].z), fp8c(v[q][2 * jp].w), w0, true);
                w1 = __builtin_amdgcn_cvt_pk_fp8_f32(fp8c(v[q][2 * jp + 1].x), fp8c(v[q][2 * jp + 1].y), w1, false); w1 = __builtin_amdgcn_cvt_pk_fp8_f32(fp8c(v[q][2 * jp + 1].z), fp8c(v[q][2 * jp + 1].w), w1, true);
                v2u w; w.x = (unsigned)w0; w.y = (unsigned)w1; *(v2u*)(H8 + (size_t)(tokb + q) * D + 512 * jp + 8 * lane) = w; }
        }
    }
}

__device__ __forceinline__ void norm_router_phase(const Ctx& C, int layer) {
    LAS float* wrT = (LAS float*)C.lds;
    const float* wr = C.in_router + (size_t)layer * D * NE;
    for (int i0 = C.tid; i0 < D * NE / 4; i0 += 512 * 8) { f32x4 wv[8];
#pragma unroll
        for (int u = 0; u < 8; ++u) wv[u] = *(const f32x4*)(wr + 4 * (i0 + 512 * u));
#pragma unroll
        for (int u = 0; u < 8; ++u) { const int i = i0 + 512 * u, col = i >> 2, e0 = (i & 3) * 4; const f32x4 w = wv[u];
            wrT[(e0 + 0) * D + col] = w.x; wrT[(e0 + 1) * D + col] = w.y; wrT[(e0 + 2) * D + col] = w.z; wrT[(e0 + 3) * D + col] = w.w; } }
    __syncthreads();
    const float* modl = (const float*)(C.ws + WS_MOD) + (size_t)layer * NB * 6144;
    const float* gain = C.in_norm2 + layer * D;
    unsigned char* H8 = C.ws + WS_H;
    float* aff = (float*)(C.ws + WS_AFF);
    RowMod M; M.bcur = -1;
    const int lane = C.lane;
    for (int i = 0; i < TOK_PER_WAVE / TB; ++i) {
        const int tokb = C.blk * TOK_PER_BLK + C.wave * TOK_PER_WAVE + TB * i, b = tokb >> 11;
        if (b != M.bcur) load_rowmod(M, modl, gain, b, 3, lane);
        const bf16* xr = (const bf16*)(C.ws + WS_XB) + (size_t)tokb * D;
        f32x4 v[TB][4]; float rinv[TB];
#pragma unroll
        for (int q = 0; q < TB; ++q) load_row_bf16(xr + q * D, v[q], lane);
        sumsq4(v, rinv);
#pragma unroll
        for (int q = 0; q < TB; ++q) {
#pragma unroll
            for (int j = 0; j < 4; ++j) v[q][j] = v[q][j] * rinv[q] * M.a[j] + M.b[j];
#pragma unroll
            for (int jp = 0; jp < 2; ++jp) { int w0 = 0, w1 = 0;
                w0 = __builtin_amdgcn_cvt_pk_fp8_f32(fp8c(v[q][2 * jp].x), fp8c(v[q][2 * jp].y), w0, false); w0 = __builtin_amdgcn_cvt_pk_fp8_f32(fp8c(v[q][2 * jp].z), fp8c(v[q][2 * jp].w), w0, true);
                w1 = __builtin_amdgcn_cvt_pk_fp8_f32(fp8c(v[q][2 * jp + 1].x), fp8c(v[q][2 * jp + 1].y), w1, false); w1 = __builtin_amdgcn_cvt_pk_fp8_f32(fp8c(v[q][2 * jp + 1].z), fp8c(v[q][2 * jp + 1].w), w1, true);
                v2u w; w.x = (unsigned)w0; w.y = (unsigned)w1; *(v2u*)(H8 + (size_t)(tokb + q) * D + 512 * jp + 8 * lane) = w; }
        }
        float p[TB][16];
#pragma unroll
        for (int e = 0; e < 16; ++e) {
            f32x4 w[4];
#pragma unroll
            for (int j = 0; j < 4; ++j) w[j] = *(const LAS f32x4*)(wrT + e * D + COLJ(j, lane));
#pragma unroll
            for (int q = 0; q < TB; ++q) { f32x4 P = v[q][0] * w[0];
#pragma unroll
                for (int j = 1; j < 4; ++j) P = v[q][j] * w[j] + P;
                p[q][e] = (P.x + P.y) + (P.z + P.w); }
            if ((e & 3) == 3) asm volatile("" : "+v"(p[0][e]), "+v"(p[1][e]), "+v"(p[2][e]), "+v"(p[3][e]) :: "memory");
        }
        float q8[TB][8], q4[TB][4], q2[TB][2], q1[TB];
        { const bool hi = (lane & 32) != 0;
#pragma unroll
          for (int k = 0; k < 8; ++k)
#pragma unroll
              for (int q = 0; q < TB; ++q) { const float keep = hi ? p[q][k + 8] : p[q][k], send = hi ? p[q][k] : p[q][k + 8]; q8[q][k] = keep + __shfl_xor(send, 32); } }
        { const bool hi = (lane & 16) != 0;
#pragma unroll
          for (int k = 0; k < 4; ++k)
#pragma unroll
              for (int q = 0; q < TB; ++q) { const float keep = hi ? q8[q][k + 4] : q8[q][k], send = hi ? q8[q][k] : q8[q][k + 4]; q4[q][k] = keep + __shfl_xor(send, 16); } }
        { const bool hi = (lane & 8) != 0;
#pragma unroll
          for (int k = 0; k < 2; ++k)
#pragma unroll
              for (int q = 0; q < TB; ++q) { const float keep = hi ? q4[q][k + 2] : q4[q][k], send = hi ? q4[q][k] : q4[q][k + 2]; q2[q][k] = keep + __shfl_xor(send, 8); } }
        { const bool hi = (lane & 4) != 0;
#pragma unroll
          for (int q = 0; q < TB; ++q) { const float keep = hi ? q2[q][1] : q2[q][0], send = hi ? q2[q][0] : q2[q][1]; q1[q] = keep + __shfl_xor(send, 4); } }
#pragma unroll
        for (int q = 0; q < TB; ++q) q1[q] += __shfl_xor(q1[q], 2);
#pragma unroll
        for (int q = 0; q < TB; ++q) q1[q] += __shfl_xor(q1[q], 1);
        float mx[TB], ex[TB], sm[TB];
#pragma unroll
        for (int q = 0; q < TB; ++q) mx[q] = q1[q];
#pragma unroll
        for (int o = 4; o < 64; o <<= 1)
#pragma unroll
            for (int q = 0; q < TB; ++q) mx[q] = fmaxf(mx[q], __shfl_xor(mx[q], o));
#pragma unroll
        for (int q = 0; q < TB; ++q) { ex[q] = expf(q1[q] - mx[q]); sm[q] = ex[q]; }
#pragma unroll
        for (int o = 4; o < 64; o <<= 1)
#pragma unroll
            for (int q = 0; q < TB; ++q) sm[q] += __shfl_xor(sm[q], o);
        if ((lane & 3) == 0) {
#pragma unroll
            for (int q = 0; q < TB; ++q) aff[(size_t)(tokb + q) * NE + (lane >> 2)] = ex[q] / sm[q];
        }
    }
}

__device__ __forceinline__ void norm_router_mfma_phase(const Ctx& C, int layer) {
    const float* wr = C.in_router + (size_t)layer * D * NE;
    const float* modl = (const float*)(C.ws + WS_MOD) + (size_t)layer * NB * 6144;
    const float* gain = C.in_norm2 + layer * D;
    const int tok0 = C.blk * TOK_PER_BLK, b0 = tok0 >> 11, b1 = (tok0 + TOK_PER_BLK - 1) >> 11, lane = C.lane;
    LAS unsigned char* wP = C.lds; LAS float* ta = (LAS float*)(C.lds + 98304); LAS float* tb = ta + 1024; LAS float* tc = tb + 1024; LAS float* red = tc + 16;
    unsigned char* H8 = C.ws + WS_H;
    float* aff = (float*)(C.ws + WS_AFF);
#pragma nounroll
    for (int sidx = 0; sidx < 2; ++sidx) {
        if (sidx == 1 && b1 == b0) break;
        const int b = sidx ? b1 : b0;
        int lane_ = lane; asm volatile("" : "+v"(lane_));
        const int t = lane_ & 15, kq = lane_ >> 4; int tid_ = C.tid; asm volatile("" : "+v"(tid_));
        const int ix16 = (lane_ ^ 16) << 2, ix32 = (lane_ ^ 32) << 2;
#define RX(v, ix) __builtin_bit_cast(float, __builtin_amdgcn_ds_bpermute((ix), __builtin_bit_cast(int, (v))))
        if (sidx == 1) __syncthreads();
        const float* mb = modl + (size_t)b * 6144;
        { float g[2], sc[2], sh[2];
#pragma unroll
          for (int u = 0; u < 2; ++u) { const int k = tid_ + 512 * u; g[u] = gain[k]; sc[u] = mb[4 * 1024 + k]; sh[u] = mb[3 * 1024 + k]; }
#pragma unroll
          for (int u = 0; u < 2; ++u) { const int k = tid_ + 512 * u; ta[k] = g[u] * (sc[u] + 1.0f); tb[k] = sh[u]; } }
        __syncthreads();
        {
            float wv[4][8], cp = 0.f;
            const float* wlane = wr + (size_t)(C.wave * 16 + kq) * 8 * NE + t; asm volatile("" : "+v"(wlane));
#pragma unroll
            for (int p = 0; p < 4; ++p)
#pragma unroll
                for (int i = 0; i < 8; ++i) wv[p][i] = wlane[(32 * p + i) * NE];
#pragma unroll
            for (int p = 0; p < 4; ++p) { const int k8 = (C.wave * 4 + p) * 4 + kq;
                const f32x4 a0 = *(const LAS f32x4*)(ta + 8 * k8), a1 = *(const LAS f32x4*)(ta + 8 * k8 + 4), s0 = *(const LAS f32x4*)(tb + 8 * k8), s1 = *(const LAS f32x4*)(tb + 8 * k8 + 4);
                const float av[8] = {a0.x, a0.y, a0.z, a0.w, a1.x, a1.y, a1.z, a1.w}, sv[8] = {s0.x, s0.y, s0.z, s0.w, s1.x, s1.y, s1.z, s1.w};
                unsigned h1[8], h2[8], h3[8];
#pragma unroll
                for (int i = 0; i < 8; ++i) { const float w = wv[p][i] * av[i]; cp += wv[p][i] * sv[i];
                    h1[i] = f2bf(w); const float r1 = w - __builtin_bit_cast(float, h1[i] << 16);
                    h2[i] = f2bf(r1); const float r2 = r1 - __builtin_bit_cast(float, h2[i] << 16);
                    h3[i] = f2bf(r2); }
                v4u o1, o2, o3;
                o1.x = h1[0] | (h1[1] << 16); o1.y = h1[2] | (h1[3] << 16); o1.z = h1[4] | (h1[5] << 16); o1.w = h1[6] | (h1[7] << 16);
                o2.x = h2[0] | (h2[1] << 16); o2.y = h2[2] | (h2[3] << 16); o2.z = h2[4] | (h2[5] << 16); o2.w = h2[6] | (h2[7] << 16);
                o3.x = h3[0] | (h3[1] << 16); o3.y = h3[2] | (h3[3] << 16); o3.z = h3[4] | (h3[5] << 16); o3.w = h3[6] | (h3[7] << 16);
                *(LAS v4u*)(wP + ((0 * 128 + k8) * 16 + t) * 16) = o1; *(LAS v4u*)(wP + ((1 * 128 + k8) * 16 + t) * 16) = o2; *(LAS v4u*)(wP + ((2 * 128 + k8) * 16 + t) * 16) = o3;
                asm volatile("" : "+v"(cp) :: "memory"); }
            cp += RX(cp, ix16); cp += RX(cp, ix32);
            if (kq == 0) red[C.wave * 16 + t] = cp;
        }
        __syncthreads();
        if (tid_ < 16) { float sacc = 0.f;
#pragma unroll
            for (int w = 0; w < NWAVES; ++w) sacc += red[w * 16 + tid_];
            tc[tid_] = sacc; }
        __syncthreads();
        for (int gi = C.wave; gi < TOK_PER_BLK / 16; gi += NWAVES) {
            const int tokg = tok0 + 16 * gi;
            if ((tokg >> 11) != b) continue;
            const bf16* xrow = (const bf16*)(C.ws + WS_XB) + (size_t)(tokg + t) * D + 16 * kq;
            v4u raw[16][2];
#pragma unroll
            for (int ch = 0; ch < 16; ++ch) { raw[ch][0] = *(const v4u*)(xrow + ch * 64); raw[ch][1] = *(const v4u*)(xrow + ch * 64 + 8); }
            f32x4 acc1 = (f32x4){0.f, 0.f, 0.f, 0.f}, acc2 = acc1, acc3 = acc1, accS = acc1;
            const LAS unsigned char* wl = wP + (2 * kq * 16 + t) * 16;
            bf16x8 W1 = *(const LAS bf16x8*)(wl), W2 = *(const LAS bf16x8*)(wl + 128 * 256), W3 = *(const LAS bf16x8*)(wl + 2 * 128 * 256);
#pragma unroll
            for (int st = 0; st < 32; ++st) {
                bf16x8 N1 = W1, N2 = W2, N3 = W3;
                if (st < 31) { const LAS unsigned char* wn = wl + (((st + 1) >> 1) * 8 + ((st + 1) & 1)) * 256; N1 = *(const LAS bf16x8*)(wn); N2 = *(const LAS bf16x8*)(wn + 128 * 256); N3 = *(const LAS bf16x8*)(wn + 2 * 128 * 256); }
                const bf16x8 xb = __builtin_bit_cast(bf16x8, raw[st >> 1][st & 1]);
                __builtin_amdgcn_sched_barrier(0);
                acc1 = __builtin_amdgcn_mfma_f32_16x16x32_bf16(W1, xb, acc1, 0, 0, 0);
                acc2 = __builtin_amdgcn_mfma_f32_16x16x32_bf16(W2, xb, acc2, 0, 0, 0);
                acc3 = __builtin_amdgcn_mfma_f32_16x16x32_bf16(W3, xb, acc3, 0, 0, 0);
                accS = __builtin_amdgcn_mfma_f32_16x16x32_bf16(xb, xb, accS, 0, 0, 0);
                W1 = N1; W2 = N2; W3 = N3;
            }
            const float dsel = (t & 2) ? ((t & 1) ? accS.w : accS.z) : ((t & 1) ? accS.y : accS.x);
            const float ss = RX(dsel, (t + 16 * (t >> 2)) << 2);
            const float rinv = 1.0f / sqrtf(ss * (1.0f / D) + EPS);
            const f32x4 cv = *(const LAS f32x4*)(tc + 4 * kq);
            f32x4 lg = ((acc3 + acc2) + acc1) * rinv + cv;
            float mx = fmaxf(fmaxf(lg.x, lg.y), fmaxf(lg.z, lg.w));
            mx = fmaxf(mx, RX(mx, ix16)); mx = fmaxf(mx, RX(mx, ix32));
            f32x4 ex; ex.x = expf(lg.x - mx); ex.y = expf(lg.y - mx); ex.z = expf(lg.z - mx); ex.w = expf(lg.w - mx);
            float sm = (ex.x + ex.y) + (ex.z + ex.w);
            sm += RX(sm, ix16); sm += RX(sm, ix32);
            *(f32x4*)(aff + (size_t)(tokg + t) * NE + 4 * kq) = ex / sm;
            unsigned char* hrow = H8 + (size_t)(tokg + t) * D + 16 * kq;
#pragma unroll
            for (int ch = 0; ch < 16; ++ch) {
                unsigned ow[4];
#pragma unroll
                for (int hf = 0; hf < 2; ++hf) {
                    v4u w = raw[ch][hf]; asm volatile("" : "+v"(w)); const int c0 = ch * 64 + 16 * kq + 8 * hf;
                    const f32x4 a0 = *(const LAS f32x4*)(ta + c0), a1 = *(const LAS f32x4*)(ta + c0 + 4), s0 = *(const LAS f32x4*)(tb + c0), s1 = *(const LAS f32x4*)(tb + c0 + 4);
                    const f32x4 x0 = (f32x4){bf_lo(w.x), bf_hi(w.x), bf_lo(w.y), bf_hi(w.y)}, x1 = (f32x4){bf_lo(w.z), bf_hi(w.z), bf_lo(w.w), bf_hi(w.w)};
                    const f32x4 h0 = x0 * rinv * a0 + s0, h1 = x1 * rinv * a1 + s1;
                    int w0 = 0, w1 = 0;
                    w0 = __builtin_amdgcn_cvt_pk_fp8_f32(fp8c(h0.x), fp8c(h0.y), w0, false); w0 = __builtin_amdgcn_cvt_pk_fp8_f32(fp8c(h0.z), fp8c(h0.w), w0, true);
                    w1 = __builtin_amdgcn_cvt_pk_fp8_f32(fp8c(h1.x), fp8c(h1.y), w1, false); w1 = __builtin_amdgcn_cvt_pk_fp8_f32(fp8c(h1.z), fp8c(h1.w), w1, true);
                    ow[2 * hf] = (unsigned)w0; ow[2 * hf + 1] = (unsigned)w1;
                }
                v4u o; o.x = ow[0]; o.y = ow[1]; o.z = ow[2]; o.w = ow[3]; *(v4u*)(hrow + ch * 64) = o;
            }
        }
    }
}
#undef RX

constexpr int AT_KPITCH = 128, AT_VPITCH = 1056, AT_VOFF = 16 * 32 * AT_KPITCH, AT_RPB = AT_VOFF + 64 * AT_VPITCH;
__device__ __forceinline__ int att_ksw(int key) { return ((key >> 1) * 3) & 7; }
struct AttItem { int b, h, j, r0, nlo, cnt, kc0; };
__device__ __forceinline__ AttItem att_item(int xcd, int ci, int n) {
    AttItem I; const int oct = n & 3, pair = xcd * 48 + 8 * (n >> 2) + (ci >> 2);
    I.j = ci & 3; I.h = pair & 15; I.b = pair >> 4; I.r0 = 8 * oct;
    I.nlo = oct == 0 ? 0 : 8 * oct + 3; I.cnt = oct == 0 ? 11 : (oct == 3 ? 5 : 8);
    int kc0 = 16 * I.j - 8; I.kc0 = kc0 < 0 ? 0 : (kc0 > 32 ? 32 : kc0); return I;
}
__device__ __forceinline__ void att_issue(const AttItem& I, const bf16* Q, const bf16* Kb, const bf16* VT, int tid, int wave, int lane, v4u (&kreg)[6], v4u (&vreg)[6], v4u (&qreg)[2]) {
    const size_t tok0 = (size_t)I.b * TSEQ + (size_t)I.nlo * 64 + I.kc0;
    const char* kbase = (const char*)(Kb + tok0 * D + I.h * HD);
    const char* vbase = (const char*)(VT + ((size_t)((I.b * NHEAD + I.h) * 32 + I.nlo) * 8 + (I.kc0 >> 3)) * 512);
    asm volatile("" : "+v"(tid));
#pragma unroll
    for (int u = 0; u < 6; ++u) {
        const int ci = tid + 512 * u, key = ci >> 3, chunk = ci & 7, krow = key >> 5, kcol = key & 31;
        if (krow < I.cnt) kreg[u] = *(const v4u*)(kbase + (unsigned)((krow * 64 + kcol) * (D * 2) + chunk * 16));
        const int d = ci & 63, vch = (ci >> 6) & 3, vr = ci >> 8;
        if (vr < I.cnt) vreg[u] = *(const v4u*)(vbase + (unsigned)(((vr * 8 + vch) * 64 + d) * 16));
    }
    const int fr = lane & 15, fq = lane >> 4;
    const size_t tokq = (size_t)I.b * TSEQ + (I.r0 + wave) * 64 + 16 * I.j + fr;
#pragma unroll
    for (int ks = 0; ks < 2; ++ks) qreg[ks] = *(const v4u*)(Q + tokq * D + I.h * HD + 32 * ks + 8 * fq);
}
__device__ __forceinline__ void att_fill(const AttItem& I, LAS unsigned char* lds, int tid, const v4u (&kreg)[6], const v4u (&vreg)[6]) {
    asm volatile("" : "+v"(tid));
#pragma unroll
    for (int u = 0; u < 6; ++u) {
        const int ci = tid + 512 * u, key = ci >> 3, chunk = ci & 7, krow = key >> 5, kcol = key & 31;
        if (krow < I.cnt) { const int sk = ((I.nlo + krow) & 15) * 32 + kcol; *(LAS v4u*)(lds + sk * AT_KPITCH + ((chunk ^ att_ksw(sk)) << 4)) = kreg[u]; }
        const int d = ci & 63, vch = (ci >> 6) & 3, vr = ci >> 8;
        if (vr < I.cnt) *(LAS v4u*)(lds + AT_VOFF + d * AT_VPITCH + ((I.nlo + vr) & 15) * 64 + vch * 16) = vreg[u];
    }
}
__device__ __forceinline__ void attn_phase(const Ctx& C) {
    const bf16* Q = (const bf16*)(C.ws + WS_Q); const bf16* Kb = (const bf16*)(C.ws + WS_K); const bf16* VT = (const bf16*)(C.ws + WS_VT);
    bf16* O = (bf16*)(C.ws + WS_H);
    const int tid = C.tid, lane = C.lane, wave = C.wave, fr = lane & 15, fq = lane >> 4;
    LAS unsigned char* lds = C.lds;
    LAS float* rp = (LAS float*)(lds + AT_RPB);
    const float shift = *(const float*)(C.ws + WS_SHIFT) * 1.4426950408889634f;
    constexpr int PER = 24;
    const int xcd_ = C.blk & 7, ci_ = C.blk >> 3;
    v4u kregA[6], vregA[6], qregA[2], kregB[6], vregB[6], qregB[2];
    { const AttItem I0 = att_item(xcd_, ci_, 0); att_issue(I0, Q, Kb, VT, tid, wave, lane, kregA, vregA, qregA); const AttItem I1 = att_item(xcd_, ci_, 1); att_issue(I1, Q, Kb, VT, tid, wave, lane, kregB, vregB, qregB); }
    int hcur = -1;
#define ATT_RROW(i) (((rs + (i)) & 15))
#define ATT_LDK(dst, i) do { const LAS unsigned char* kr_ = kp + ATT_RROW(i) * (32 * AT_KPITCH); dst[0] = *(const LAS bf16x8*)(kr_ + kc0_); dst[1] = *(const LAS bf16x8*)(kr_ + (kc0_ ^ 64)); dst[2] = *(const LAS bf16x8*)(kr_ + 4 * AT_KPITCH + kc1_); dst[3] = *(const LAS bf16x8*)(kr_ + 4 * AT_KPITCH + (kc1_ ^ 64)); } while (0)
#define ATT_STEP(NN, KR, VR, QR) do { \
 \
        const AttItem J = att_item(xcd_, ci_, NN); \
        att_fill(J, lds, tid, KR, VR); \
        if (J.h != hcur) { \
            const v4u* src = (const v4u*)(C.ws + WS_RPT) + (size_t)J.h * 960; \
            const v4u t0 = src[tid], t1 = tid < 448 ? src[tid + 512] : (v4u){0u, 0u, 0u, 0u}; \
            ((LAS v4u*)rp)[tid] = t0; if (tid < 448) ((LAS v4u*)rp)[tid + 512] = t1; \
            hcur = J.h; } \
        bf16x8 Qf[2]; Qf[0] = __builtin_bit_cast(bf16x8, QR[0]); Qf[1] = __builtin_bit_cast(bf16x8, QR[1]); \
        __syncthreads(); \
 \
        if (NN + 2 < PER) { const AttItem I2 = att_item(xcd_, ci_, NN + 2); att_issue(I2, Q, Kb, VT, tid, wave, lane, KR, VR, QR); } \
 \
        const int r = J.r0 + wave; int rs = r - 4; rs = rs < 0 ? 0 : (rs > 24 ? 24 : rs); \
        const int qc = 16 * J.j + fr; \
        int start = qc - 8; start = start < 0 ? 0 : (start > 48 ? 48 : start); \
        float msk[8]; \
        _Pragma("unroll") \
        for (int T = 0; T < 2; ++T) \
        _Pragma("unroll") \
            for (int jj = 0; jj < 4; ++jj) { const int rel = J.kc0 + 8 * fq + 4 * T + jj - start; msk[4 * T + jj] = ((unsigned)rel < 16u) ? -shift : -1e30f; } \
 \
        const int bi = 16 + J.kc0 + 8 * fq - qc + 15; \
        const LAS float* bp = rp + ((bi & 3) * 15 + (rs - r + 7)) * 64 + (bi & ~3); \
        const int key0 = 8 * (fr >> 2) + (fr & 3); \
        const LAS unsigned char* kp = lds + key0 * AT_KPITCH; \
        const int kc0_ = (fq ^ att_ksw(key0)) << 4, kc1_ = (fq ^ att_ksw(key0 + 4)) << 4; \
        const LAS unsigned char* vp = lds + AT_VOFF + fr * AT_VPITCH + 16 * fq; \
        f32x4 Oa[4]; float sum = 0.f; \
        _Pragma("unroll") \
        for (int dt = 0; dt < 4; ++dt) Oa[dt] = (f32x4){0.f, 0.f, 0.f, 0.f}; \
 \
        bf16x8 Kc[4], Kn[4]; f32x4 Bc[2], Bn[2]; \
        ATT_LDK(Kc, 0); \
        Bc[0] = *(const LAS f32x4*)(bp); Bc[1] = *(const LAS f32x4*)(bp + 4); \
        _Pragma("unroll") \
        for (int i8 = 0; i8 < 8; ++i8) { \
            if (i8 < 7) { ATT_LDK(Kn, i8 + 1); Bn[0] = *(const LAS f32x4*)(bp + (i8 + 1) * 64); Bn[1] = *(const LAS f32x4*)(bp + (i8 + 1) * 64 + 4); } \
            bf16x8 Vf[4]; \
        _Pragma("unroll") \
            for (int dt = 0; dt < 4; ++dt) Vf[dt] = *(const LAS bf16x8*)(vp + ATT_RROW(i8) * 64 + dt * 16 * AT_VPITCH); \
            f32x4 S[2]; \
        _Pragma("unroll") \
            for (int T = 0; T < 2; ++T) { \
                f32x4 sv = Bc[T] + (f32x4){msk[4 * T], msk[4 * T + 1], msk[4 * T + 2], msk[4 * T + 3]}; \
                sv = __builtin_amdgcn_mfma_f32_16x16x32_bf16(Kc[2 * T], Qf[0], sv, 0, 0, 0); \
                sv = __builtin_amdgcn_mfma_f32_16x16x32_bf16(Kc[2 * T + 1], Qf[1], sv, 0, 0, 0); \
                S[T] = sv; \
            } \
            float pv[8]; \
        _Pragma("unroll") \
            for (int T = 0; T < 2; ++T) \
        _Pragma("unroll") \
                for (int jj = 0; jj < 4; ++jj) { const float p = __builtin_amdgcn_exp2f(S[T][jj]); pv[4 * T + jj] = p; sum += p; } \
            v4u w; w.x = cvt2bf(pv[0], pv[1]); w.y = cvt2bf(pv[2], pv[3]); w.z = cvt2bf(pv[4], pv[5]); w.w = cvt2bf(pv[6], pv[7]); \
            const bf16x8 Pf = __builtin_bit_cast(bf16x8, w); \
        _Pragma("unroll") \
            for (int dt = 0; dt < 4; ++dt) Oa[dt] = __builtin_amdgcn_mfma_f32_16x16x32_bf16(Vf[dt], Pf, Oa[dt], 0, 0, 0); \
            if (i8 < 7) { \
        _Pragma("unroll") \
                for (int q = 0; q < 4; ++q) Kc[q] = Kn[q]; \
                Bc[0] = Bn[0]; Bc[1] = Bn[1]; \
            } \
        } \
        sum += __shfl_xor(sum, 16); sum += __shfl_xor(sum, 32); \
        const float inv = 1.0f / sum; \
        bf16* op = O + ((size_t)J.b * TSEQ + r * 64 + qc) * D + J.h * HD + 4 * fq; \
        _Pragma("unroll") \
        for (int dt = 0; dt < 4; ++dt) { v2u w; w.x = cvt2bf(Oa[dt][0] * inv, Oa[dt][1] * inv); w.y = cvt2bf(Oa[dt][2] * inv, Oa[dt][3] * inv); *(v2u*)(op + 16 * dt) = w; } \
        __syncthreads(); \
    } while (0)
    for (int n = 0; n < PER; n += 2) { ATT_STEP(n, kregA, vregA, qregA); ATT_STEP(n + 1, kregB, vregB, qregB); }
#undef ATT_STEP
#undef ATT_LDK
#undef ATT_RROW
}

__device__ __forceinline__ unsigned pidx(unsigned i) { return i + (i >> 6); }
__device__ __forceinline__ void select_bin(const LAS unsigned* hist, int nb, unsigned want, volatile LAS unsigned* res, int lane) {
    const int per = nb >> 6; unsigned s = 0;
    for (int k = 0; k < per; ++k) s += hist[lane * per + k];
    unsigned t = s;
#pragma unroll
    for (int o = 1; o < 64; o <<= 1) { const unsigned u = __shfl_down(t, o); if (lane + o < 64) t += u; }
    const unsigned above = t - s;
    if (above < want && want <= t) {
        unsigned a = above;
        for (int k = per - 1; k >= 0; --k) { const unsigned hh = hist[lane * per + k]; if (a + hh >= want) { res[0] = (unsigned)(lane * per + k); res[1] = a; break; } a += hh; }
    }
}
__device__ __forceinline__ void topk_block(const Ctx& C) {
    const int tid = C.tid, lane = C.lane, wave = C.wave;
    const int g = C.blk >> 4, e = C.blk & 15;
    const int n = g ? (NT - NP) : NP, cap = n >> 3, tok0 = g ? NP : 0, slot0 = g ? SLOT_S0 + e * CAP_S : e * CAP_P;
    LAS unsigned* keys = (LAS unsigned*)C.lds;
    LAS unsigned* hist = (LAS unsigned*)(C.lds + 133120);
    volatile LAS unsigned* res = (volatile LAS unsigned*)(C.lds + 141312);
    const float* aff = (const float*)(C.ws + WS_AFF);
    for (int i0 = tid; i0 < n; i0 += 512 * 8) { float av[8];
#pragma unroll
        for (int u = 0; u < 8; ++u) av[u] = aff[(size_t)(tok0 + i0 + 512 * u) * NE + e];
#pragma unroll
        for (int u = 0; u < 8; ++u) keys[pidx((unsigned)(i0 + 512 * u))] = __builtin_bit_cast(unsigned, av[u]); }
    for (int i = tid; i < 2048; i += 512) hist[i] = 0u;
    __syncthreads();
    for (int i = tid; i < n; i += 512) __hip_atomic_fetch_add(&hist[keys[pidx(i)] >> 21], 1u, __ATOMIC_RELAXED, __HIP_MEMORY_SCOPE_WORKGROUP);
    __syncthreads();
    if (wave == 0) select_bin(hist, 2048, (unsigned)cap, res, lane);
    __syncthreads();
    const unsigned binA = res[0]; unsigned want = (unsigned)cap - res[1];
    __syncthreads();
    for (int i = tid; i < 2048; i += 512) hist[i] = 0u;
    __syncthreads();
    for (int i = tid; i < n; i += 512) { const unsigned k = keys[pidx(i)]; if ((k >> 21) == binA) __hip_atomic_fetch_add(&hist[(k >> 10) & 2047u], 1u, __ATOMIC_RELAXED, __HIP_MEMORY_SCOPE_WORKGROUP); }
    __syncthreads();
    if (wave == 0) select_bin(hist, 2048, want, res, lane);
    __syncthreads();
    const unsigned binB = res[0]; want -= res[1];
    __syncthreads();
    for (int i = tid; i < 2048; i += 512) hist[i] = 0u;
    __syncthreads();
    const unsigned hiAB = (binA << 11) | binB;
    for (int i = tid; i < n; i += 512) { const unsigned k = keys[pidx(i)]; if ((k >> 10) == hiAB) __hip_atomic_fetch_add(&hist[k & 1023u], 1u, __ATOMIC_RELAXED, __HIP_MEMORY_SCOPE_WORKGROUP); }
    __syncthreads();
    if (wave == 0) select_bin(hist, 1024, want, res, lane);
    __syncthreads();
    const unsigned binC = res[0]; const unsigned rtie = want - res[1];
    const unsigned T = (hiAB << 10) | binC;
    const int L = n >> 9;
    unsigned cg = 0, ce = 0;
    for (int k = 0; k < L; ++k) { const unsigned key = keys[pidx((unsigned)(tid * L + k))]; cg += key > T ? 1u : 0u; ce += key == T ? 1u : 0u; }
    unsigned ig = cg, ie = ce;
#pragma unroll
    for (int o = 1; o < 64; o <<= 1) { const unsigned ug = __shfl_up(ig, o), ue = __shfl_up(ie, o); if (lane >= o) { ig += ug; ie += ue; } }
    if (lane == 63) { res[16 + wave] = ig; res[32 + wave] = ie; }
    __syncthreads();
    unsigned pg = ig - cg, pe = ie - ce;
    for (int w = 0; w < wave; ++w) { pg += res[16 + w]; pe += res[32 + w]; }
    int* idx = (int*)(C.ws + WS_IDX); int* smapT = (int*)(C.ws + WS_SMAP) + (size_t)e * NT + tok0;
    for (int k = 0; k < L; ++k) {
        const unsigned pi = pidx((unsigned)(tid * L + k));
        const unsigned key = keys[pi];
        const bool isg = key > T, ise = key == T, sel = isg || (ise && pe < rtie);
        const unsigned slot = pg + (pe < rtie ? pe : rtie);
        keys[pi] = sel ? (unsigned)(slot0 + slot) : 0xffffffffu;
        if (sel) idx[slot0 + slot] = tok0 + tid * L + k;
        pg += isg ? 1u : 0u; pe += ise ? 1u : 0u;
    }
    __syncthreads();
    for (int i = tid; i < n; i += 512) smapT[i] = (int)keys[pidx(i)];
    __syncthreads();
}
__device__ __forceinline__ void transpose64_item(const float* W, int ldw, int k0, int n0, bf16* dst, int ldd, LAS unsigned char* scr, int lane) {
    const int kq = lane >> 4, nq = lane & 15;
    f32x4 v[16];
    const float* src = W + (size_t)(k0 + 16 * kq) * ldw + n0 + 4 * nq;
#pragma unroll
    for (int i = 0; i < 16; ++i) v[i] = __builtin_nontemporal_load((const f32x4*)(src + (size_t)i * ldw));
#pragma unroll
    for (int j = 0; j < 4; ++j) {
        v4u lo, hi;
        lo.x = pk2(v[0][j], v[1][j]); lo.y = pk2(v[2][j], v[3][j]); lo.z = pk2(v[4][j], v[5][j]); lo.w = pk2(v[6][j], v[7][j]);
        hi.x = pk2(v[8][j], v[9][j]); hi.y = pk2(v[10][j], v[11][j]); hi.z = pk2(v[12][j], v[13][j]); hi.w = pk2(v[14][j], v[15][j]);
        LAS unsigned char* p = scr + (4 * nq + j) * 144 + kq * 32;
        *(LAS v4u*)p = lo; *(LAS v4u*)(p + 16) = hi;
    }
    LDS_WAIT(); asm volatile("" ::: "memory");
    const int c = lane & 7;
#pragma unroll
    for (int jj = 0; jj < 8; ++jj) { const int n = (lane >> 3) + 8 * jj; const v4u o = *(const LAS v4u*)(scr + n * 144 + c * 16); *(v4u*)(dst + (size_t)n * ldd + k0 + 8 * c) = o; }
    LDS_WAIT(); asm volatile("" ::: "memory");
}
__device__ __forceinline__ void transpose_fp8_item(const float* W, int ldw, int k0, int n0, unsigned char* dst, int ldd, LAS unsigned char* scr, int lane, float scale) {
    const int kq = lane >> 3, nq = lane & 7;
    f32x4 v[16];
    const float* src = W + (size_t)(k0 + 16 * kq) * ldw + n0 + 4 * nq;
#pragma unroll
    for (int i = 0; i < 16; ++i) v[i] = __builtin_nontemporal_load((const f32x4*)(src + (size_t)i * ldw));
#pragma unroll
    for (int j = 0; j < 4; ++j) {
        int w[4];
#pragma unroll
        for (int g = 0; g < 4; ++g) { int t = 0; t = __builtin_amdgcn_cvt_pk_fp8_f32(fp8c(v[4 * g][j] * scale), fp8c(v[4 * g + 1][j] * scale), t, false); t = __builtin_amdgcn_cvt_pk_fp8_f32(fp8c(v[4 * g + 2][j] * scale), fp8c(v[4 * g + 3][j] * scale), t, true); w[g] = t; }
        v4u o; o.x = (unsigned)w[0]; o.y = (unsigned)w[1]; o.z = (unsigned)w[2]; o.w = (unsigned)w[3];
        *(LAS v4u*)(scr + (4 * nq + j) * 144 + kq * 16) = o;
    }
    LDS_WAIT(); asm volatile("" ::: "memory");
    const int c = lane & 7;
#pragma unroll
    for (int jj = 0; jj < 4; ++jj) { const int n = (lane >> 3) + 8 * jj; const v4u o = *(const LAS v4u*)(scr + n * 144 + c * 16); *(v4u*)(dst + (size_t)n * ldd + k0 + 16 * c) = o; }
    LDS_WAIT(); asm volatile("" ::: "memory");
}
struct CvItem { const float* src; unsigned char* dst; int ldw, ldd; };
__device__ __forceinline__ CvItem cv_desc(const Ctx& C, int layer, unsigned char* BT1, unsigned char* BT2, int it) {
    const int e = it / 1536, rem = it % 1536, mat = rem >> 9, r2 = rem & 511;
    const size_t woff = (size_t)(layer * NE + e) * D * FF; CvItem d;
    if (mat < 2) {
        const int kb = r2 >> 6, n0 = (r2 & 63) * 32, row = 256 * (n0 >> 7) + (mat ? 128 : 0) + (n0 & 127);
        d.src = (mat ? C.in_up : C.in_gate) + woff + (size_t)(kb * 128) * FF + n0; d.ldw = FF; d.dst = BT1 + (size_t)e * 4096 * D + (size_t)row * D + kb * 128; d.ldd = D;
    } else {
        const int kb = r2 >> 5, n0 = (r2 & 31) * 32;
        d.src = C.in_down + woff + (size_t)(kb * 128) * D + n0; d.ldw = D; d.dst = BT2 + (size_t)e * D * FF + (size_t)n0 * FF + kb * 128; d.ldd = FF;
    }
    return d;
}
__device__ __forceinline__ void cv_load(const CvItem& d, f32x4 (&v)[16], int lane) {
    const float* src = d.src + (size_t)(16 * (lane >> 3)) * d.ldw + 4 * (lane & 7);
#pragma unroll
    for (int i = 0; i < 16; ++i) v[i] = __builtin_nontemporal_load((const f32x4*)(src + (size_t)i * d.ldw));
}
__device__ __forceinline__ void cv_finish(const CvItem& d, const f32x4 (&v)[16], LAS unsigned char* scr, int lane) {
    const int kq = lane >> 3, nq = lane & 7;
#pragma unroll
    for (int j = 0; j < 4; ++j) {
        int w[4];
#pragma unroll
        for (int g = 0; g < 4; ++g) { int t = 0; t = __builtin_amdgcn_cvt_pk_fp8_f32(fp8c(v[4 * g][j] * 32.0f), fp8c(v[4 * g + 1][j] * 32.0f), t, false); t = __builtin_amdgcn_cvt_pk_fp8_f32(fp8c(v[4 * g + 2][j] * 32.0f), fp8c(v[4 * g + 3][j] * 32.0f), t, true); w[g] = t; }
        v4u o; o.x = (unsigned)w[0]; o.y = (unsigned)w[1]; o.z = (unsigned)w[2]; o.w = (unsigned)w[3];
        *(LAS v4u*)(scr + (4 * nq + j) * 144 + kq * 16) = o;
    }
    LDS_WAIT(); asm volatile("" ::: "memory");
    const int c = lane & 7;
#pragma unroll
    for (int jj = 0; jj < 4; ++jj) { const int n = (lane >> 3) + 8 * jj; const v4u o = *(const LAS v4u*)(scr + n * 144 + c * 16); *(v4u*)(d.dst + (size_t)n * d.ldd + 16 * c) = o; }
    LDS_WAIT(); asm volatile("" ::: "memory");
}
__device__ __forceinline__ void moe_convert_range(const Ctx& C, int layer, unsigned char* BT1, unsigned char* BT2, int gw, int NGW, int lo, int hi) {
    LAS unsigned char* scr = C.lds + C.wave * 16384;
    int it = lo + gw; if (it >= hi) return;
    f32x4 va[16], vb[16]; CvItem da = cv_desc(C, layer, BT1, BT2, it), db = da;
    cv_load(da, va, C.lane);
    for (;;) {
        const int itb = it + NGW; const bool hb = itb < hi;
        if (hb) { db = cv_desc(C, layer, BT1, BT2, itb); cv_load(db, vb, C.lane); }
        cv_finish(da, va, scr, C.lane);
        if (!hb) break;
        it = itb + NGW; const bool ha = it < hi;
        if (ha) { da = cv_desc(C, layer, BT1, BT2, it); cv_load(da, va, C.lane); }
        cv_finish(db, vb, scr, C.lane);
        if (!ha) break;
    }
}
constexpr int CV_ITEMS = NE * 1536;
__device__ __forceinline__ void combine_phase(const Ctx& C, int layer, bool do_norm) {
    const float* modl = (const float*)(C.ws + WS_MOD) + (size_t)layer * NB * 6144;
    const float* modn = (const float*)(C.ws + WS_MOD) + (size_t)(layer + 1) * NB * 6144;
    const float* gain = C.in_norm1 + (layer + 1) * D;
    const unsigned char* Y = C.ws + WS_Y; bf16* H = (bf16*)(C.ws + WS_H);
    const float* aff = (const float*)(C.ws + WS_AFF); const int* smap = (const int*)(C.ws + WS_SMAP);
    const int lane = C.lane;
    RowMod M; M.bcur = -1; f32x4 g2v[4]; int bg = -1;
    LAS float* wn = (LAS float*)C.lds;
    if (do_norm) { float wv[8];
#pragma unroll
        for (int u = 0; u < 8; ++u) wv[u] = ((const float*)(C.ws + WS_WN))[C.tid + 512 * u];
#pragma unroll
        for (int u = 0; u < 8; ++u) wn[C.tid + 512 * u] = wv[u];
        __syncthreads(); }
    for (int i = 0; i < TOK_PER_WAVE / TB; ++i) {
        const int tokb = C.blk * TOK_PER_BLK + C.wave * TOK_PER_WAVE + TB * i, b = tokb >> 11;
        if (b != bg) {
#pragma unroll
            for (int j = 0; j < 4; ++j) g2v[j] = *(const f32x4*)(modl + (size_t)b * 6144 + 5 * 1024 + COLJ(j, lane));
            bg = b; }
        const int sm = smap[(size_t)(lane & 15) * NT + tokb + (lane >> 4)]; const float af = aff[(size_t)tokb * NE + (lane >> 4) * NE + (lane & 15)];
        bf16* xr = (bf16*)(C.ws + WS_XB) + (size_t)tokb * D; float* outr = C.out + (size_t)tokb * D;
        f32x4 v[TB][4];
#pragma unroll
        for (int q = 0; q < TB; ++q) load_row_bf16(xr + q * D, v[q], lane);
        const unsigned long long maskall = __ballot(sm >= 0);
#pragma unroll
        for (int q = 0; q < TB; ++q) {
            f32x4 acc[4];
#pragma unroll
            for (int j = 0; j < 4; ++j) acc[j] = (f32x4){0.f, 0.f, 0.f, 0.f};
            unsigned mask = (unsigned)(maskall >> (16 * q)) & 0xffffu;
            while (mask) {
                const int e0 = __builtin_ctz(mask); mask &= mask - 1u;
                const bool two = mask != 0u; const int e1 = two ? __builtin_ctz(mask) : e0; if (two) mask &= mask - 1u;
                const int s0 = __shfl(sm, 16 * q + e0), s1 = __shfl(sm, 16 * q + e1);
                const float a0 = __shfl(af, 16 * q + e0), a1 = two ? __shfl(af, 16 * q + e1) : 0.f;
                const unsigned char* y0 = Y + (size_t)s0 * D + 8 * lane; const unsigned char* y1 = Y + (size_t)s1 * D + 8 * lane;
                v2u w0[2], w1[2];
#pragma unroll
                for (int jp = 0; jp < 2; ++jp) { w0[jp] = *(const v2u*)(y0 + 512 * jp); w1[jp] = *(const v2u*)(y1 + 512 * jp); }
#pragma unroll
                for (int jp = 0; jp < 2; ++jp) {
                    typedef float f32x2_ __attribute__((ext_vector_type(2)));
                    const f32x2_ p0 = __builtin_amdgcn_cvt_pk_f32_fp8((int)w0[jp].x, false), p1 = __builtin_amdgcn_cvt_pk_f32_fp8((int)w0[jp].x, true), p2 = __builtin_amdgcn_cvt_pk_f32_fp8((int)w0[jp].y, false), p3 = __builtin_amdgcn_cvt_pk_f32_fp8((int)w0[jp].y, true);
                    const f32x2_ r0 = __builtin_amdgcn_cvt_pk_f32_fp8((int)w1[jp].x, false), r1 = __builtin_amdgcn_cvt_pk_f32_fp8((int)w1[jp].x, true), r2 = __builtin_amdgcn_cvt_pk_f32_fp8((int)w1[jp].y, false), r3 = __builtin_amdgcn_cvt_pk_f32_fp8((int)w1[jp].y, true);
                    acc[2 * jp].x += a0 * p0.x; acc[2 * jp].y += a0 * p0.y; acc[2 * jp].z += a0 * p1.x; acc[2 * jp].w += a0 * p1.y;
                    acc[2 * jp + 1].x += a0 * p2.x; acc[2 * jp + 1].y += a0 * p2.y; acc[2 * jp + 1].z += a0 * p3.x; acc[2 * jp + 1].w += a0 * p3.y;
                    acc[2 * jp].x += a1 * r0.x; acc[2 * jp].y += a1 * r0.y; acc[2 * jp].z += a1 * r1.x; acc[2 * jp].w += a1 * r1.y;
                    acc[2 * jp + 1].x += a1 * r2.x; acc[2 * jp + 1].y += a1 * r2.y; acc[2 * jp + 1].z += a1 * r3.x; acc[2 * jp + 1].w += a1 * r3.y; }
            }
#pragma unroll
            for (int j = 0; j < 4; ++j) v[q][j] = v[q][j] + g2v[j] * acc[j];
            if (do_norm) store_row_bf16(xr + q * D, v[q], lane);
            else {
#pragma unroll
                for (int j = 0; j < 4; ++j) *(f32x4*)(outr + q * D + COLJ(j, lane)) = v[q][j];
            }
        }
        if (do_norm) {
            if (b != M.bcur) load_rowmod(M, modn, gain, b, 0, lane);
            float rinv[TB];
            sumsq4(v, rinv);
#pragma unroll
            for (int q = 0; q < TB; ++q) {
#pragma unroll
                for (int j = 0; j < 4; ++j) v[q][j] = v[q][j] * rinv[q] * M.a[j] + M.b[j];
                store_row_bf16(H + (size_t)(tokb + q) * D, v[q], lane);
            }
            float p[16];
#pragma unroll
            for (int g = 0; g < 4; ++g) {
                f32x4 w[4];
#pragma unroll
                for (int j = 0; j < 4; ++j) w[j] = *(const LAS f32x4*)(wn + g * D + COLJ(j, lane));
#pragma unroll
                for (int q = 0; q < TB; ++q) { f32x4 P = v[q][0] * w[0];
#pragma unroll
                    for (int j = 1; j < 4; ++j) P = v[q][j] * w[j] + P;
                    p[q * 4 + g] = (P.x + P.y) + (P.z + P.w); }
                asm volatile("" : "+v"(p[g]), "+v"(p[4 + g]), "+v"(p[8 + g]), "+v"(p[12 + g]) :: "memory");
            }
            float q8[8], q4[4], q2[2], q1;
            { const bool hi = (lane & 32) != 0;
#pragma unroll
              for (int k = 0; k < 8; ++k) { const float keep = hi ? p[k + 8] : p[k], send = hi ? p[k] : p[k + 8]; q8[k] = keep + __shfl_xor(send, 32); } }
            { const bool hi = (lane & 16) != 0;
#pragma unroll
              for (int k = 0; k < 4; ++k) { const float keep = hi ? q8[k + 4] : q8[k], send = hi ? q8[k] : q8[k + 4]; q4[k] = keep + __shfl_xor(send, 16); } }
            { const bool hi = (lane & 8) != 0;
#pragma unroll
              for (int k = 0; k < 2; ++k) { const float keep = hi ? q4[k + 2] : q4[k], send = hi ? q4[k] : q4[k + 2]; q2[k] = keep + __shfl_xor(send, 8); } }
            { const bool hi = (lane & 4) != 0; const float keep = hi ? q2[1] : q2[0], send = hi ? q2[0] : q2[1]; q1 = keep + __shfl_xor(send, 4); }
            q1 += __shfl_xor(q1, 2); q1 += __shfl_xor(q1, 1);
            if ((lane & 3) == 0) ((float*)(C.ws + WS_V128))[(size_t)tokb * 4 + (lane >> 2)] = q1;
        }
    }
}

__device__ __forceinline__ void f128_task(const Ctx& C) {
    LAS float* ct = (LAS float*)C.lds;
    LAS f32x4* vb = (LAS f32x4*)(C.lds + 8192);
    for (int i = C.tid; i < 2048; i += 512) { float s, c; sincospif((float)i * (1.0f / 1024.0f), &s, &c); ct[i] = c; }
    const f32x4* V = (const f32x4*)(C.ws + WS_V128); float* F = (float*)(C.ws + WS_F128);
    const int lane = C.lane;
    const int it0 = C.blk * (NT / 256), it1 = it0 + NT / 256;
    for (int bb = it0 >> 11; bb <= (it1 - 1) >> 11; ++bb) {
        __syncthreads();
        { f32x4 t4[4];
#pragma unroll
          for (int u = 0; u < 4; ++u) t4[u] = V[(size_t)bb * TSEQ + C.tid + 512 * u];
#pragma unroll
          for (int u = 0; u < 4; ++u) vb[C.tid + 512 * u] = t4[u]; }
        __syncthreads();
        const int lo = it0 > (bb << 11) ? it0 : (bb << 11), hi = it1 < ((bb + 1) << 11) ? it1 : ((bb + 1) << 11);
        for (int it = lo + C.wave; it < hi; it += NWAVES) {
            const int k1 = it & 2047;
            f32x4 acc = (f32x4){0.f, 0.f, 0.f, 0.f};
#pragma unroll 8
            for (int i = 0; i < 32; ++i) { const int t = lane + 64 * i; const float c = ct[(k1 * t) & 2047]; acc = acc + vb[t] * c; }
            float r2[2], r1;
            { const bool hi5 = (lane & 32) != 0; const float k0 = hi5 ? acc.z : acc.x, s0 = hi5 ? acc.x : acc.z, k1v = hi5 ? acc.w : acc.y, s1 = hi5 ? acc.y : acc.w; r2[0] = k0 + __shfl_xor(s0, 32); r2[1] = k1v + __shfl_xor(s1, 32); }
            { const bool hi4 = (lane & 16) != 0; const float keep = hi4 ? r2[1] : r2[0], send = hi4 ? r2[0] : r2[1]; r1 = keep + __shfl_xor(send, 16); }
            r1 += __shfl_xor(r1, 8); r1 += __shfl_xor(r1, 4); r1 += __shfl_xor(r1, 2); r1 += __shfl_xor(r1, 1);
            if ((lane & 15) == 0) F[(size_t)it * 4 + (lane >> 4)] = r1 * 0.022097086912079608f;
        }
    }
}

template <int MODE> struct Sched : pg8::OrderBase {
    const char* A0; const char* B0; size_t sA, sB, sE;
    __device__ __forceinline__ bool next(int i, pg8::Unit& u) const {
        if (!idx(i, u.pm, u.pn)) return false;
        if (MODE == 0) { u.A = A0 + (size_t)u.pm * sA; u.B = B0 + (size_t)u.pn * sB; }
        if (MODE == 1) { const int e = u.pm < 256 ? (u.pm >> 4) : ((u.pm - 256) >> 3); u.A = A0 + (size_t)u.pm * sA; u.B = B0 + (size_t)e * sE + (size_t)u.pn * sB; }
        if (MODE == 2) { u.A = A0 + (size_t)(u.pm & 7) * sA; u.B = B0 + (size_t)(u.pm >> 3) * sE + (size_t)u.pn * sB; }
        if (MODE == 3) { const int q = u.pm & 3;
            u.A = A0 + (size_t)((u.pn >> 1) * 2 + (q >> 1)) * (sA * 2) + (size_t)(q & 1) * sA; u.B = B0 + (size_t)(((u.pm >> 2) * 2 + (u.pn >> 1)) * 2 + (q >> 1)) * sE + (size_t)(u.pn & 1) * sB; }
        if (MODE == 4) { u.A = A0 + (size_t)u.pm * sA; u.B = B0 + (size_t)((u.pn >> 3) * 2048 + (u.pn & 7) * 128) * sB; }
        return true;
    }
};
typedef pg8::f32x4 (&AccRef)[2][2][4][2];

struct EpiQK {
    static constexpr bool PERM = true; static constexpr int NVM = 16;
    bf16* Q; bf16* Kb; const float* qg; const float* kg;
    __device__ __forceinline__ void operator()(const pg8::f32x4 (&acc)[2][2][4][2], const pg8::Unit& u, int wr, int wc, int fr, int fq) const {
        const int sec = u.pn >> 2, head = 4 * (u.pn & 3) + wc;
        bf16* out = (sec ? Kb : Q) + head * HD + 8 * fq;
        const float* gp = (sec ? kg : qg) + 8 * fq; const float scl = sec ? 1.0f : 0.125f * 1.4426950408889634f;
        f32x4 g[2][2];
#pragma unroll
        for (int bj = 0; bj < 2; ++bj)
#pragma unroll
            for (int n = 0; n < 2; ++n) g[bj][n] = *(const f32x4*)(gp + 32 * bj + 4 * n) * (scl * 0.03125f);
        const int row0 = u.pm * 256 + wr * 64 + fr;
#pragma unroll
        for (int ai = 0; ai < 2; ++ai)
#pragma unroll
            for (int m = 0; m < 4; ++m) {
                float ss = 0.f;
#pragma unroll
                for (int bj = 0; bj < 2; ++bj)
#pragma unroll
                    for (int n = 0; n < 2; ++n) { const f32x4 x = acc[ai][bj][m][n]; ss += (x.x * x.x + x.y * x.y) + (x.z * x.z + x.w * x.w); }
                ss += __shfl_xor(ss, 16); ss += __shfl_xor(ss, 32);
                const float rinv = 1.0f / sqrtf(ss * (1.0f / (HD * 1024.0f)) + EPS);
                bf16* rowp = out + (size_t)(row0 + ai * 128 + m * 16) * D;
#pragma unroll
                for (int bj = 0; bj < 2; ++bj) { const f32x4 v0 = acc[ai][bj][m][0] * rinv * g[bj][0], v1 = acc[ai][bj][m][1] * rinv * g[bj][1];
                    v4u w; w.x = pg8::cvt_pk_bf16(v0.x, v0.y); w.y = pg8::cvt_pk_bf16(v0.z, v0.w); w.z = pg8::cvt_pk_bf16(v1.x, v1.y); w.w = pg8::cvt_pk_bf16(v1.z, v1.w);
                    *(v4u*)(rowp + 32 * bj) = w; }
            }
    }
};
template <int MODE> struct EpiStore {
    static constexpr bool PERM = true; static constexpr int NVM = 16;
    bf16* O; size_t ldc; float scale;
    __device__ __forceinline__ void operator()(const pg8::f32x4 (&acc)[2][2][4][2], const pg8::Unit& u, int wr, int wc, int fr, int fq) const {
        bf16* base; size_t ld;
        if (MODE == 0) { base = O + (size_t)u.pm * 256 * ldc + (size_t)u.pn * 256; ld = ldc; }
        else { const int part = u.pm >> 1, col0 = (u.pm & 1) * 256, b = u.pn >> 3, t0 = (u.pn & 7) * 256; base = O + (((size_t)(b * 2 + part) * 512 + col0) * 2048 + t0); ld = 2048; }
        base += (size_t)(wr * 64 + fr) * ld + wc * 32 + 8 * fq;
#pragma unroll
        for (int ai = 0; ai < 2; ++ai)
#pragma unroll
            for (int m = 0; m < 4; ++m) { bf16* rowp = base + (size_t)(ai * 128 + m * 16) * ld;
#pragma unroll
                for (int bj = 0; bj < 2; ++bj) { const f32x4 v0 = acc[ai][bj][m][0] * scale, v1 = acc[ai][bj][m][1] * scale;
                    v4u w; w.x = pg8::cvt_pk_bf16(v0.x, v0.y); w.y = pg8::cvt_pk_bf16(v0.z, v0.w); w.z = pg8::cvt_pk_bf16(v1.x, v1.y); w.w = pg8::cvt_pk_bf16(v1.z, v1.w);
                    *(v4u*)(rowp + bj * 128) = w; } }
    }
};
struct EpiEO {
    static constexpr bool PERM = true; static constexpr int NVM = 16;
    bf16* O;
    __device__ __forceinline__ void operator()(const pg8::f32x4 (&acc)[2][2][4][2], const pg8::Unit& u, int wr, int wc, int fr, int fq) const {
        const int part = u.pm >> 1, ch0 = (u.pm & 1) * 256 + wr * 64 + fr, b = u.pn >> 3, t0 = (u.pn & 7) * 128 + wc * 32 + 8 * fq;
        bf16* be = O + ((((size_t)(b * 2 + part) * 2) * 512 + ch0) * 1024 + t0); bf16* bo = be + (size_t)512 * 1024;
#pragma unroll
        for (int ai = 0; ai < 2; ++ai)
#pragma unroll
            for (int m = 0; m < 4; ++m) { const size_t ro = (size_t)(ai * 128 + m * 16) * 1024;
                const f32x4 e0 = acc[ai][0][m][0] + acc[ai][1][m][0], e1 = acc[ai][0][m][1] + acc[ai][1][m][1], o0 = acc[ai][0][m][0] - acc[ai][1][m][0], o1 = acc[ai][0][m][1] - acc[ai][1][m][1];
                v4u w; w.x = pg8::cvt_pk_bf16(e0.x, e0.y); w.y = pg8::cvt_pk_bf16(e0.z, e0.w); w.z = pg8::cvt_pk_bf16(e1.x, e1.y); w.w = pg8::cvt_pk_bf16(e1.z, e1.w);
                *(v4u*)(be + ro) = w;
                v4u x; x.x = pg8::cvt_pk_bf16(o0.x, o0.y); x.y = pg8::cvt_pk_bf16(o0.z, o0.w); x.z = pg8::cvt_pk_bf16(o1.x, o1.y); x.w = pg8::cvt_pk_bf16(o1.z, o1.w);
                *(v4u*)(bo + ro) = x; }
    }
};
struct EpiY8 {
    static constexpr bool PERM = true; static constexpr int NVM = 16;
    unsigned char* Y;
    __device__ __forceinline__ void operator()(const pg8::f32x4 (&acc)[2][2][4][2], const pg8::Unit& u, int wr, int wc, int fr, int fq) const {
        unsigned char* base = Y + (size_t)(u.pm * 256 + wr * 64 + fr) * D + (size_t)u.pn * 256 + wc * 32 + 8 * fq;
#pragma unroll
        for (int ai = 0; ai < 2; ++ai)
#pragma unroll
            for (int m = 0; m < 4; ++m)
#pragma unroll
                for (int bj = 0; bj < 2; ++bj) { const f32x4 v0 = acc[ai][bj][m][0] * 0.03125f, v1 = acc[ai][bj][m][1] * 0.03125f; int w0 = 0, w1 = 0;
                    w0 = __builtin_amdgcn_cvt_pk_fp8_f32(fp8c(v0.x), fp8c(v0.y), w0, false); w0 = __builtin_amdgcn_cvt_pk_fp8_f32(fp8c(v0.z), fp8c(v0.w), w0, true);
                    w1 = __builtin_amdgcn_cvt_pk_fp8_f32(fp8c(v1.x), fp8c(v1.y), w1, false); w1 = __builtin_amdgcn_cvt_pk_fp8_f32(fp8c(v1.z), fp8c(v1.w), w1, true);
                    v2u w; w.x = (unsigned)w0; w.y = (unsigned)w1; *(v2u*)(base + (size_t)(ai * 128 + m * 16) * D + bj * 128) = w; }
    }
};
struct EpiVT {
    static constexpr bool PERM = true; static constexpr int NVM = 16;
    bf16* VT;
    __device__ __forceinline__ void operator()(const pg8::f32x4 (&acc)[2][2][4][2], const pg8::Unit& u, int wr, int wc, int fr, int fq) const {
#pragma unroll
        for (int ai = 0; ai < 2; ++ai)
#pragma unroll
            for (int m = 0; m < 4; ++m) { const int rho = u.pm * 256 + ai * 128 + wr * 64 + m * 16 + fr, h = rho >> 6, d = rho & 63;
#pragma unroll
                for (int bj = 0; bj < 2; ++bj) { const int tau = u.pn * 256 + bj * 128 + wc * 32 + 8 * fq, b = tau >> 11, r = (tau >> 6) & 31, cg = (tau >> 3) & 7;
                    const f32x4 v0 = acc[ai][bj][m][0] * 0.03125f, v1 = acc[ai][bj][m][1] * 0.03125f;
                    v4u w; w.x = pg8::cvt_pk_bf16(v0.x, v0.y); w.y = pg8::cvt_pk_bf16(v0.z, v0.w); w.z = pg8::cvt_pk_bf16(v1.x, v1.y); w.w = pg8::cvt_pk_bf16(v1.z, v1.w);
                    *(v4u*)(VT + ((size_t)(((b * NHEAD + h) * 32 + r) * 8 + cg) * 64 + d) * 8) = w; } }
    }
};
struct EpiPQ {
    static constexpr bool PERM = true; static constexpr int NVM = 32;
    bf16* O; const float* F128;
    __device__ __forceinline__ void operator()(const pg8::f32x4 (&acc)[2][2][4][2], const pg8::Unit& u, int wr, int wc, int fr, int fq) const {
        const int b = u.pm >> 2, q = u.pm & 3, par = q >> 1, r0 = (q & 1) * 256 + wr * 64 + fr;
        bf16* base = O + (size_t)b * TSEQ * D + (size_t)u.pn * 256 + wc * 32 + 8 * fq;
        const bool inj = (u.pn >= 2) && (wc == 0) && (fq == 0);
        const float qs = u.pn >= 2 ? -1.0f : 1.0f;
#pragma unroll
        for (int ai = 0; ai < 2; ++ai)
#pragma unroll
            for (int m = 0; m < 4; ++m) { const int k = 2 * (r0 + ai * 128 + m * 16) + par, km = (TSEQ - k) & (TSEQ - 1);
                bf16* rowp = base + (size_t)k * D; bf16* rowm = base + (size_t)km * D;
                f32x4 fz = (f32x4){0.f, 0.f, 0.f, 0.f}, fm = fz;
                if (inj) { fz = *(const f32x4*)(F128 + ((size_t)b * TSEQ + k) * 4); fm = *(const f32x4*)(F128 + ((size_t)b * TSEQ + km) * 4); }
#pragma unroll
                for (int bj = 0; bj < 2; ++bj) { f32x4 v0 = acc[ai][bj][m][0]; const f32x4 v1 = acc[ai][bj][m][1]; f32x4 m0 = v0 * qs; const f32x4 m1 = v1 * qs;
                    if (inj) { const int g = 2 * (u.pn - 2) + bj; v0.x = g == 0 ? fz.x : (g == 1 ? fz.y : (g == 2 ? fz.z : fz.w)); m0.x = g == 0 ? fm.x : (g == 1 ? fm.y : (g == 2 ? fm.z : fm.w)); }
                    v4u w; w.x = pg8::cvt_pk_bf16(v0.x, v0.y); w.y = pg8::cvt_pk_bf16(v0.z, v0.w); w.z = pg8::cvt_pk_bf16(v1.x, v1.y); w.w = pg8::cvt_pk_bf16(v1.z, v1.w);
                    *(v4u*)(rowp + bj * 128) = w;
                    if (k != 0) { v4u x; x.x = pg8::cvt_pk_bf16(m0.x, m0.y); x.y = pg8::cvt_pk_bf16(m0.z, m0.w); x.z = pg8::cvt_pk_bf16(m1.x, m1.y); x.w = pg8::cvt_pk_bf16(m1.z, m1.w);
                        *(v4u*)(rowm + bj * 128) = x; } } }
    }
};
__device__ __forceinline__ void pq_nyq_task(const Ctx& C) {
    const bf16* VT2 = (const bf16*)(C.ws + WS_VT2); bf16* H = (bf16*)(C.ws + WS_H); const float* F128 = (const float*)(C.ws + WS_F128);
    const int lane = C.lane;
    if (C.blk < 128) return;
    for (int row = (C.blk - 128) * NWAVES + C.wave; row < NB * 512; row += 128 * NWAVES) {
        const int b = row >> 9, c = row & 511;
        const bf16* src = VT2 + ((size_t)(b * 2) * 2 * 512 + c) * 1024 + lane * 16;
        float s = 0.f;
#pragma unroll
        for (int j = 0; j < 2; ++j) { const v4u w = *(const v4u*)(src + 8 * j);
            s += (bf_lo(w.x) - bf_hi(w.x)) + (bf_lo(w.y) - bf_hi(w.y)) + (bf_lo(w.z) - bf_hi(w.z)) + (bf_lo(w.w) - bf_hi(w.w)); }
#pragma unroll
        for (int o = 1; o < 64; o <<= 1) s += __shfl_xor(s, o);
        if (lane == 0) H[((size_t)b * TSEQ + 1024) * D + c] = (bf16)f2bf(s * 0.022097086912079608f);
    }
    if (C.blk < 128 + NB && C.wave == 0) {
        const size_t tok = (size_t)(C.blk - 128) * TSEQ + 1024;
        const float f = (lane & 15) == 0 ? F128[tok * 4 + (lane >> 4)] : 0.f;
        v4u w; w.x = pk2(f, 0.f); w.y = 0u; w.z = 0u; w.w = 0u;
        *(v4u*)(H + tok * D + 512 + lane * 8) = w;
    }
}
struct EpiRes {
    static constexpr bool PERM = true; static constexpr int NVM = 16;
    const float* xp; const float* xs; bf16* XB; const float* modg; int src_is_xb;
    __device__ __forceinline__ void operator()(const pg8::f32x4 (&acc)[2][2][4][2], const pg8::Unit& u, int wr, int wc, int fr, int fq) const {
        const int row0 = u.pm * 256 + wr * 64 + fr, col0 = u.pn * 256 + wc * 32 + 8 * fq, b = u.pm >> 3;
        const float* gb = modg + (size_t)b * 6144 + col0;
        f32x4 gv[2][2];
#pragma unroll
        for (int bj = 0; bj < 2; ++bj)
#pragma unroll
            for (int n = 0; n < 2; ++n) gv[bj][n] = *(const f32x4*)(gb + bj * 128 + 4 * n);
        const float* X = u.pm < 128 ? xp : xs - (size_t)NP * D;
#pragma unroll
        for (int ai = 0; ai < 2; ++ai)
#pragma unroll
            for (int m = 0; m < 4; ++m) { const size_t off = (size_t)(row0 + ai * 128 + m * 16) * D + col0;
#pragma unroll
                for (int bj = 0; bj < 2; ++bj) {
                    f32x4 x0, x1;
                    if (src_is_xb) { const v4u w = *(const v4u*)(XB + off + bj * 128); x0 = (f32x4){bf_lo(w.x), bf_hi(w.x), bf_lo(w.y), bf_hi(w.y)}; x1 = (f32x4){bf_lo(w.z), bf_hi(w.z), bf_lo(w.w), bf_hi(w.w)}; }
                    else { x0 = *(const f32x4*)(X + off + bj * 128); x1 = *(const f32x4*)(X + off + bj * 128 + 4); }
                    const f32x4 v0 = x0 + gv[bj][0] * acc[ai][bj][m][0], v1 = x1 + gv[bj][1] * acc[ai][bj][m][1];
                    v4u o; o.x = pg8::cvt_pk_bf16(v0.x, v0.y); o.y = pg8::cvt_pk_bf16(v0.z, v0.w); o.z = pg8::cvt_pk_bf16(v1.x, v1.y); o.w = pg8::cvt_pk_bf16(v1.z, v1.w);
                    *(v4u*)(XB + off + bj * 128) = o; } }
    }
};
struct EpiAct {
    static constexpr bool PERM = true; static constexpr int NVM = 8;
    unsigned char* ACT;
    __device__ __forceinline__ void operator()(const pg8::f32x4 (&acc)[2][2][4][2], const pg8::Unit& u, int wr, int wc, int fr, int fq) const {
        unsigned char* base = ACT + (size_t)u.pm * 256 * FF + (size_t)u.pn * 128 + wc * 32 + 8 * fq + (size_t)(wr * 64 + fr) * FF;
#pragma unroll
        for (int ai = 0; ai < 2; ++ai)
#pragma unroll
            for (int m = 0; m < 4; ++m) {
                float hv[8];
#pragma unroll
                for (int n = 0; n < 2; ++n) { const f32x4 A = acc[ai][0][m][n], U = acc[ai][1][m][n]; f32x4 T = A * (-0.03125f * 1.4426950408889634f);
#pragma unroll
                    for (int j = 0; j < 4; ++j) T[j] = __builtin_amdgcn_exp2f(T[j]);
                    T = T + 1.0f;
#pragma unroll
                    for (int j = 0; j < 4; ++j) T[j] = __builtin_amdgcn_rcpf(T[j]);
                    const f32x4 Hh = (A * U) * (T * (0.03125f * 0.03125f));
#pragma unroll
                    for (int j = 0; j < 4; ++j) hv[4 * n + j] = Hh[j]; }
                int w0 = 0, w1 = 0;
                w0 = __builtin_amdgcn_cvt_pk_fp8_f32(fp8c(hv[0]), fp8c(hv[1]), w0, false); w0 = __builtin_amdgcn_cvt_pk_fp8_f32(fp8c(hv[2]), fp8c(hv[3]), w0, true);
                w1 = __builtin_amdgcn_cvt_pk_fp8_f32(fp8c(hv[4]), fp8c(hv[5]), w1, false); w1 = __builtin_amdgcn_cvt_pk_fp8_f32(fp8c(hv[6]), fp8c(hv[7]), w1, true);
                v2u w; w.x = (unsigned)w0; w.y = (unsigned)w1;
                *(v2u*)(base + (size_t)(ai * 128 + m * 16) * FF) = w;
            }
    }
};

constexpr int NPH = 20;
typedef const __attribute__((address_space(4))) Args* KArgP;
__device__ __forceinline__ KArgP kargs() { KArgP p = (KArgP)__builtin_amdgcn_kernarg_segment_ptr(); asm volatile("" : "+s"(p)); return p; }
#define MKCTX(C) Ctx C; { KArgP a_ = kargs(); C.lds = (LAS unsigned char*)lds_raw; { unsigned z_ = 0u; asm volatile("" : "+s"(z_)); C.tid = (wave << 6) | (int)__builtin_amdgcn_mbcnt_hi(~0u, __builtin_amdgcn_mbcnt_lo(~0u, z_)); } asm volatile("" : "+v"(C.tid)); __builtin_assume((unsigned)C.tid < 512u);   C.lane = C.tid & 63; C.wave = wave; C.G = (int)gridDim.x; C.blk = (int)blockIdx.x; \
    C.in_xp = a_->in[0]; C.in_xs = a_->in[1]; C.in_cp = a_->in[2]; C.in_cs = a_->in[3]; C.in_norm1 = a_->in[4]; C.in_norm2 = a_->in[5]; \
    C.in_adaw = a_->in[6]; C.in_adab = a_->in[7]; C.in_wqkv = a_->in[8]; C.in_qg = a_->in[9]; C.in_kg = a_->in[10]; C.in_rpb = a_->in[11]; \
    C.in_wo = a_->in[12]; C.in_win = a_->in[13]; C.in_wout = a_->in[14]; C.in_router = a_->in[15]; C.in_gate = a_->in[16]; C.in_up = a_->in[17]; C.in_down = a_->in[18]; \
    C.out = a_->out; C.ws = a_->ws; }

#ifndef PH_ONLY
#define PH_ONLY -1
#endif
#define IN(k) ((PH_ONLY < 0 || PH_ONLY == (k) || (PH_ONLY >= 100 && PH_ONLY - 100 == ((k) > 10 ? (k) - 9 : (k)))) && lo <= (k) && (k) < hi)
#define SEAM(k) do { if (IN(k) && IN((k) + 1)) xcd_barrier(bar); } while (0)
extern __shared__ __attribute__((aligned(16))) unsigned char lds_raw[];
template <int l> __device__ __forceinline__ void layer_phases(const int tid, const int wave, const int lo, const int hi, const XcdBarrier& bar) {
        if constexpr (l == 0) {
            if (IN(1)) { MKCTX(C); norm_rows_phase(C); p0_rest(C); } SEAM(1);
            if (IN(2)) {
                {
                    MKCTX(C); unsigned char* ws = C.ws;
                    Sched<0> S; S.init(NT / 256, 8, C.G, C.blk); S.A0 = (const char*)(ws + WS_H); S.B0 = (const char*)(ws + WS_BTQK); S.sA = 256 * D; S.sB = 256 * D; S.sE = 0;
                    EpiQK E{(bf16*)(ws + WS_Q), (bf16*)(ws + WS_K), C.in_qg, C.in_kg};
                    pg8::gemm_phase<EpiQK, Sched<0>, true, true>(C.lds, D, D, D, S, E, nullptr, C.tid);
                }
                {
                    MKCTX(C); unsigned char* ws = C.ws;
                    Sched<0> S; S.init(4, NT / 256, C.G, C.blk); S.A0 = (const char*)(ws + WS_BTV); S.B0 = (const char*)(ws + WS_H); S.sA = 256 * D; S.sB = 256 * D; S.sE = 0;
                    EpiVT E{(bf16*)(ws + WS_VT)};
                    pg8::gemm_phase<EpiVT, Sched<0>, true, true, false, true>(C.lds, D, D, D, S, E, nullptr, C.tid);
                }
            } SEAM(2);
            if (IN(3)) { MKCTX(C); attn_phase(C); __syncthreads(); } SEAM(3);
        } else {
            if (IN(11)) {
                MKCTX(C); unsigned char* ws = C.ws;
                Sched<4> S; S.init(4, NT / 256, C.G, C.blk); S.A0 = (const char*)(ws + WS_BTIN); S.B0 = (const char*)(ws + WS_H); S.sA = 256 * D * 2; S.sB = D * 2; S.sE = 0;
                EpiEO E{(bf16*)(ws + WS_VT2)};
                pg8::gemm_phase<EpiEO, Sched<4>, true, false, false, false, true>(C.lds, D * 2, D * 2, D * 2, S, E, nullptr, C.tid, (size_t)1024 * D * 2);
                f128_task(C);
                __syncthreads();
            } SEAM(11);
            if (IN(12)) {
                MKCTX(C); unsigned char* ws = C.ws;
                Sched<3> S; S.init(NB * 4, 4, C.G, C.blk); S.A0 = (const char*)(ws + WS_CS); S.B0 = (const char*)(ws + WS_VT2); S.sA = (size_t)256 * 1024 * 2; S.sB = (size_t)256 * 1024 * 2; S.sE = (size_t)512 * 1024 * 2;
                EpiPQ E{(bf16*)(ws + WS_H), (const float*)(ws + WS_F128)};
                pg8::gemm_phase<EpiPQ, Sched<3>, true, false, false, false, true>(C.lds, 2048, 2048, 2048, S, E, nullptr, C.tid);
                pq_nyq_task(C);
            } SEAM(12);
        }
        {
            const int pid = l == 0 ? 4 : 13;
            if (IN(pid)) {
                MKCTX(C); unsigned char* ws = C.ws;
                Sched<0> S; S.init(NT / 256, 4, C.G, C.blk); S.A0 = (const char*)(ws + WS_H); S.B0 = (const char*)(ws + (l == 0 ? WS_BTO : WS_BTOUT)); S.sA = 256 * D * 2; S.sB = 256 * D * 2; S.sE = 0;
                EpiRes E{C.in_xp, C.in_xs, (bf16*)(ws + WS_XB), (const float*)(ws + WS_MOD) + (size_t)l * NB * 6144 + 2 * 1024, l};
                pg8::gemm_phase<EpiRes, Sched<0>, true, false, false, false, true>(C.lds, D * 2, D * 2, D * 2, S, E, nullptr, C.tid);
            } SEAM(pid);
        }
        const int q0 = l == 0 ? 5 : 14;
        if (IN(q0)) { MKCTX(C); norm_router_mfma_phase(C, l); __syncthreads(); } SEAM(q0);
        if (IN(q0 + 1)) { MKCTX(C); if (C.blk < 32) topk_block(C);
            else moe_convert_range(C, l, C.ws + WS_BT1, C.ws + WS_BT2, (C.blk - 32) * NWAVES + C.wave, (C.G - 32) * NWAVES, 0, CV_ITEMS);
            __syncthreads(); } SEAM(q0 + 1);
        if (IN(q0 + 3)) {
            MKCTX(C); unsigned char* ws = C.ws;
            Sched<1> S; S.init(NSLOT / 256, 16, C.G, C.blk); S.A0 = (const char*)(ws + WS_H); S.B0 = (const char*)(ws + WS_BT1); S.sA = 0; S.sB = 256 * D; S.sE = (size_t)4096 * D;
            LAS unsigned* gtab = (LAS unsigned*)(C.lds + RING_BYTES);
            { const int* idx = (const int*)(ws + WS_IDX); LAS int* pmt = (LAS int*)(C.lds + RING_BYTES + 24 * 1024);
              if (C.tid < 24) { int pm = 0, pn = 0; (void)S.idx(C.tid, pm, pn); pmt[C.tid] = pm; }
              __syncthreads();
              int tk[12];
#pragma unroll
              for (int k = 0; k < 12; ++k) tk[k] = idx[pmt[2 * k + (C.tid >> 8)] * 256 + (C.tid & 255)];
#pragma unroll
              for (int k = 0; k < 12; ++k) gtab[(2 * k + (C.tid >> 8)) * 256 + (C.tid & 255)] = (unsigned)tk[k] * (unsigned)D; }
            __syncthreads();
            EpiAct E{ws + WS_ACT};
            pg8::gemm_phase<EpiAct, Sched<1>, true, true, true>(C.lds, D, D, D, S, E, gtab, C.tid);
            __syncthreads();
        } SEAM(q0 + 3);
        if (IN(q0 + 4)) {
            MKCTX(C); unsigned char* ws = C.ws;
            Sched<1> S; S.init(NSLOT / 256, 4, C.G, C.blk); S.A0 = (const char*)(ws + WS_ACT); S.B0 = (const char*)(ws + WS_BT2); S.sA = (size_t)256 * FF; S.sB = (size_t)256 * FF; S.sE = (size_t)D * FF;
            EpiY8 E{ws + WS_Y};
            pg8::gemm_phase<EpiY8, Sched<1>, true, true, false, false, true>(C.lds, FF, FF, FF, S, E, nullptr, C.tid);
        } SEAM(q0 + 4);
        if (IN(q0 + 5)) { MKCTX(C); combine_phase(C, l, l == 0); } if (l == 0) SEAM(q0 + 5);
    }

__global__ void __launch_bounds__(NWAVES * 64, 2) trunk_fwd(Args args) {
    const int tid = threadIdx.x, wave = __builtin_amdgcn_readfirstlane(tid >> 6);
    volatile LAS unsigned* MISC = (volatile LAS unsigned*)((LAS unsigned char*)lds_raw + MISC_OFF);
    if (tid < 64) MISC[tid] = 0u;
    __syncthreads();
    XcdBarrier bar; bar.bar = (unsigned*)(args.ws + WS_CTL) + CW_BAR; bar.x = 0; bar.st = MISC + 8; bar.t0 = tid == 0;
    if (args.use_bar) bar = xcd_barrier_post((unsigned*)(args.ws + WS_CTL) + CW_BAR, MISC + 8);
    const int lo = args.ph_lo, hi = args.ph_hi;

    if (IN(0)) { MKCTX(C); p0_prologue(C); } SEAM(0);
    layer_phases<0>(tid, wave, lo, hi, bar);
    layer_phases<1>(tid, wave, lo, hi, bar);
#undef IN
#undef SEAM
}

extern "C" void kernel_launch(void* const* d_in, const int* in_sizes, int n_in, void* d_out, int out_size, void* d_ws, size_t ws_size, hipStream_t stream) {
    static int grid = 0;
    if (grid == 0) {
        if (n_in != 19 || out_size != NT * D || ws_size < WS_END) { fprintf(stderr, "kernel_launch: unexpected shapes (n_in %d, out %d, ws %zu < %zu)\n", n_in, out_size, ws_size, (size_t)WS_END); grid = -1; return; }
        int dev = 0, cus = 0;
        if (hipGetDevice(&dev) != hipSuccess || hipDeviceGetAttribute(&cus, hipDeviceAttributeMultiprocessorCount, dev) != hipSuccess) { grid = -1; return; }
        if (hipFuncSetAttribute((const void*)trunk_fwd, hipFuncAttributeMaxDynamicSharedMemorySize, LDS_BYTES) != hipSuccess) { fprintf(stderr, "kernel_launch: hipFuncSetAttribute failed\n"); grid = -1; return; }
        int per_cu = 0;
        if (hipOccupancyMaxActiveBlocksPerMultiprocessor(&per_cu, (const void*)trunk_fwd, NWAVES * 64, LDS_BYTES) != hipSuccess || per_cu < 1) fprintf(stderr, "kernel_launch: occupancy query says %d\n", per_cu);
        (void)hipGetLastError();
        grid = 256;
        if (cus < 256) fprintf(stderr, "kernel_launch: %d CUs reported, the kernel needs 256 co-resident workgroups\n", cus);
    }
    if (grid < 0) return;
    (void)hipMemsetAsync((char*)d_ws + WS_CTL, 0, CTL_ZERO_BYTES, stream);
    Args a{};
    for (int i = 0; i < 19; ++i) a.in[i] = (const float*)d_in[i];
    a.out = (float*)d_out; a.ws = (unsigned char*)d_ws; a.pad = 0;
#if MK_N_LAUNCHES == 1
    a.ph_lo = 0; a.ph_hi = NPH; a.use_bar = 1;
    hipLaunchKernelGGL(trunk_fwd, dim3(grid), dim3(NWAVES * 64), LDS_BYTES, stream, a);
#else
    for (int p = 0; p < NPH; ++p) { const int reps = 1 + ((DUP_MASK >> p) & 1); for (int r = 0; r < reps; ++r) { a.ph_lo = p; a.ph_hi = p + 1; a.use_bar = 0; hipLaunchKernelGGL(trunk_fwd, dim3(grid), dim3(NWAVES * 64), LDS_BYTES, stream, a); } }
#endif
}
```
